# Optimizing an MI355X kernel written in HIP

```python
import jax, jax.numpy as jnp
from jax import lax
import numpy as np

D_MODEL = 1024
BATCH = 1
SEQ = 16384
DEPTH = 2

GRID_W = 64
CTX_LEN = 256
HEAD_DIM = 64
ATTN_HEADS = 8
KV_HEADS = 2
GQA_GROUP = ATTN_HEADS // KV_HEADS
WINDOW = 128
BLOCK = 128
N_BAND = 2 * WINDOW // BLOCK + 1
ROPE_BASE = 10000.0
AXIS_DIM = HEAD_DIM // 2
F_GROUPS = 4
F_DIM = 64
C_HEADS = 4
C_DIM = 64
CHUNK = 128
D_FF = -(-8 * D_MODEL // (3 * 256)) * 256

ATTN_W = ATTN_HEADS * HEAD_DIM
KV_W = KV_HEADS * HEAD_DIM
F_W = F_GROUPS * F_DIM
C_W = C_HEADS * C_DIM
D_MIX = ATTN_W + F_W + C_W
D_IN = ATTN_W + 2 * KV_W + F_W + 2 * C_W
SPLITS = (ATTN_W, ATTN_W + KV_W, ATTN_W + 2 * KV_W, ATTN_W + 2 * KV_W + F_W,
          ATTN_W + 2 * KV_W + F_W + C_W)
ALPHA = (2 * DEPTH) ** 0.25
BETA = (8 * DEPTH) ** -0.25
LN_EPS = 1e-6

kernel_name = 'hymba_style_fourier_sgu_window_attn_dit'


def _ln(x):
    xf = x.astype(jnp.float32)
    mu = jnp.mean(xf, axis=-1, keepdims=True)
    var = jnp.mean(jnp.square(xf - mu), axis=-1, keepdims=True)
    return ((xf - mu) * lax.rsqrt(var + LN_EPS)).astype(x.dtype)


def _ln_affine(x, g, b):
    return _ln(x) * g + b


def _ada(cvec, w, b):
    m = (jax.nn.silu(cvec) @ w + b)[:, None, :]
    return jnp.split(m, 6, axis=-1)


def _modulate(x, shift, scale):
    return _ln(x) * (1.0 + scale) + shift


def _post_norm(x, y, gate, g, b):
    return _ln_affine(ALPHA * x + gate * y, g, b)


def _axial_rope_tables(n):
    rows = n // GRID_W
    row = jnp.repeat(jnp.arange(rows), GRID_W).astype(jnp.float32)
    col = jnp.tile(jnp.arange(GRID_W), rows).astype(jnp.float32)
    freqs = ROPE_BASE ** (-jnp.arange(0, AXIS_DIM, 2, dtype=jnp.float32) / AXIS_DIM)
    ang_r = row[:, None] * freqs
    ang_c = col[:, None] * freqs
    return (jnp.cos(ang_r), jnp.sin(ang_r), jnp.cos(ang_c), jnp.sin(ang_c))


def _rotate(x, cos, sin):
    x1, x2 = jnp.split(x, 2, axis=-1)
    cos = cos[None, :, None, :].astype(x.dtype)
    sin = sin[None, :, None, :].astype(x.dtype)
    return jnp.concatenate([x1 * cos - x2 * sin, x1 * sin + x2 * cos], axis=-1)


def _apply_axial_rope(x, rope):
    cr, sr, cc, sc = rope
    return jnp.concatenate([_rotate(x[..., :AXIS_DIM], cr, sr),
                            _rotate(x[..., AXIS_DIM:], cc, sc)], axis=-1)


def _band(t):
    B, N = t.shape[0], t.shape[1]
    nb = N // BLOCK
    tp = jnp.pad(t, ((0, 0), (WINDOW, WINDOW), (0, 0), (0, 0)))
    views = [tp[:, i * BLOCK: i * BLOCK + N].reshape(B, nb, BLOCK, KV_HEADS, HEAD_DIM)
             for i in range(N_BAND)]
    return jnp.concatenate(views, axis=2)


def _window_attention(q, k, v, kc, vc, sink):
    B, N = q.shape[0], q.shape[1]
    nb = N // BLOCK
    nw = N_BAND * BLOCK
    qb = q.reshape(B, nb, BLOCK, KV_HEADS, GQA_GROUP, HEAD_DIM) * (HEAD_DIM ** -0.5)
    kb, vb = _band(k), _band(v)
    s_win = jnp.einsum('bnqkgd,bnjkd->bkgnqj', qb, kb).astype(jnp.float32)
    q_idx = jnp.arange(BLOCK)[:, None]
    j_idx = jnp.arange(nw)[None, :]
    key_pos = jnp.arange(nb)[:, None, None] * BLOCK + j_idx[None] - WINDOW
    mask = (jnp.abs(j_idx - WINDOW - q_idx) <= WINDOW)[None] & (key_pos >= 0) & (key_pos < N)
    s_win = jnp.where(mask, s_win, -jnp.inf)
    s_ctx = jnp.einsum('bnqkgd,blkd->bkgnql', qb, kc).astype(jnp.float32)
    s_sink = jnp.broadcast_to(sink.astype(jnp.float32).reshape(1, KV_HEADS, GQA_GROUP, 1, 1, 1),
                              s_win.shape[:-1] + (1,))
    p = jax.nn.softmax(jnp.concatenate([s_win, s_ctx, s_sink], axis=-1), axis=-1).astype(v.dtype)
    L = kc.shape[1]
    o = (jnp.einsum('bkgnqj,bnjkd->bnqkgd', p[..., :nw], vb)
         + jnp.einsum('bkgnql,blkd->bnqkgd', p[..., nw:nw + L], vc))
    return o.reshape(B, N, ATTN_W)


def _context_attention(qc, kc, vc, sink):
    B, L = qc.shape[0], qc.shape[1]
    qg = qc.reshape(B, L, KV_HEADS, GQA_GROUP, HEAD_DIM) * (HEAD_DIM ** -0.5)
    s = jnp.einsum('blkgd,bmkd->bkglm', qg, kc).astype(jnp.float32)
    s_sink = jnp.broadcast_to(sink.astype(jnp.float32).reshape(1, KV_HEADS, GQA_GROUP, 1, 1),
                              s.shape[:-1] + (1,))
    p = jax.nn.softmax(jnp.concatenate([s, s_sink], axis=-1), axis=-1).astype(vc.dtype)
    o = jnp.einsum('bkglm,bmkd->blkgd', p[..., :L], vc)
    return o.reshape(B, L, ATTN_W)


def _fourier_mix(f, w_f, b_f):
    B, N = f.shape[0], f.shape[1]
    g = f.reshape(B, N, F_GROUPS, F_DIM).astype(jnp.float32)
    z = jnp.fft.fft2(g, axes=(1, 3), norm='ortho').real.astype(f.dtype)
    y = jnp.einsum('bngc,gcd->bngd', z, w_f) + b_f
    return y.reshape(B, N, F_W)


def _spatial_gating(u, v, ln_g, ln_b, w_s, b_s):
    B, N = u.shape[0], u.shape[1]
    nc = N // CHUNK
    u = jax.nn.gelu(u).reshape(B, nc, CHUNK, C_HEADS, C_DIM)
    v = _ln_affine(jax.nn.gelu(v).reshape(B, nc, CHUNK, C_HEADS, C_DIM), ln_g, ln_b)
    vs = jnp.einsum('hpq,bcqhd->bcphd', w_s, v) + b_s.T[:, :, None]
    return (u * vs).reshape(B, N, C_W)


def _split_heads(q, k, v):
    B, N = q.shape[0], q.shape[1]
    return (q.reshape(B, N, ATTN_HEADS, HEAD_DIM), k.reshape(B, N, KV_HEADS, HEAD_DIM),
            v.reshape(B, N, KV_HEADS, HEAD_DIM))


def _swiglu(h, w1, w2):
    a, b = jnp.split(h @ w1, 2, axis=-1)
    return (jax.nn.silu(a) * b) @ w2


def _layer(x, xc, c, c_ctx, rope, w_ada, b_ada, w_in, w_out, attn_sink, w_fourier, b_fourier,
           sgu_ln_g, sgu_ln_b, w_spatial, b_spatial, ln1_g, ln1_b, w_ffn_in, w_ffn_out,
           ln2_g, ln2_b, last):
    sh_m, sc_m, g_m, sh_f, sc_f, g_f = _ada(c, w_ada, b_ada)
    csh_m, csc_m, cg_m, csh_f, csc_f, cg_f = _ada(c_ctx[None], w_ada, b_ada)
    B, L = xc.shape[0], xc.shape[1]

    hc = _modulate(xc, csh_m, csc_m)
    if last:
        kc, vc = jnp.split(hc @ w_in[:, SPLITS[0]:SPLITS[2]], 2, axis=-1)
        kc = kc.reshape(B, L, KV_HEADS, HEAD_DIM)
        vc = vc.reshape(B, L, KV_HEADS, HEAD_DIM)
        xc_new = xc
    else:
        qc, kc, vc, fc, uc, gc = jnp.split(hc @ w_in, SPLITS, axis=-1)
        qc, kc, vc = _split_heads(qc, kc, vc)
        oc = jnp.concatenate([_context_attention(qc, kc, vc, attn_sink),
                              _fourier_mix(fc, w_fourier, b_fourier),
                              _spatial_gating(uc, gc, sgu_ln_g, sgu_ln_b, w_spatial, b_spatial)],
                             axis=-1)
        xc_new = _post_norm(xc, oc @ w_out, cg_m, ln1_g, ln1_b)
        xc_new = _post_norm(xc_new, _swiglu(_modulate(xc_new, csh_f, csc_f), w_ffn_in, w_ffn_out),
                            cg_f, ln2_g, ln2_b)

    h = _modulate(x, sh_m, sc_m)
    q, k, v, f, u, g = jnp.split(h @ w_in, SPLITS, axis=-1)
    q, k, v = _split_heads(q, k, v)
    q = _apply_axial_rope(q, rope)
    k = _apply_axial_rope(k, rope)
    o = jnp.concatenate([_window_attention(q, k, v, kc, vc, attn_sink),
                         _fourier_mix(f, w_fourier, b_fourier),
                         _spatial_gating(u, g, sgu_ln_g, sgu_ln_b, w_spatial, b_spatial)], axis=-1)
    x = _post_norm(x, o @ w_out, g_m, ln1_g, ln1_b)
    x = _post_norm(x, _swiglu(_modulate(x, sh_f, sc_f), w_ffn_in, w_ffn_out), g_f, ln2_g, ln2_b)
    return x, xc_new


def setup_inputs(seed: int = 0) -> dict:
    key = jax.random.key(seed)
    ks = jax.random.split(key, 24)

    def nrm(k, shape, scale):
        return jax.random.normal(k, shape, jnp.float32) * scale

    return {
        'x': nrm(ks[0], (BATCH, SEQ, D_MODEL), 1.0),
        'c': nrm(ks[1], (BATCH, D_MODEL), 1.0),
        'ctx': nrm(ks[2], (BATCH, CTX_LEN, D_MODEL), 1.0),
        'c_ctx': nrm(ks[3], (D_MODEL,), 1.0),
        'w_ada': nrm(ks[4], (DEPTH, D_MODEL, 6 * D_MODEL), 0.5 * D_MODEL ** -0.5),
        'b_ada': nrm(ks[5], (DEPTH, 6 * D_MODEL), 0.01),
        'w_in': nrm(ks[6], (DEPTH, D_MODEL, D_IN), D_MODEL ** -0.5),
        'w_out': nrm(ks[7], (DEPTH, D_MIX, D_MODEL), BETA * D_MIX ** -0.5),
        'attn_sink': nrm(ks[8], (DEPTH, ATTN_HEADS), 1.0),
        'w_fourier': nrm(ks[9], (DEPTH, F_GROUPS, F_DIM, F_DIM), F_DIM ** -0.5),
        'b_fourier': nrm(ks[10], (DEPTH, F_GROUPS, F_DIM), 0.01),
        'sgu_ln_g': 1.0 + nrm(ks[11], (DEPTH, C_HEADS, C_DIM), 0.01),
        'sgu_ln_b': nrm(ks[12], (DEPTH, C_HEADS, C_DIM), 0.01),
        'w_spatial': nrm(ks[13], (DEPTH, C_HEADS, CHUNK, CHUNK), CHUNK ** -0.5),
        'b_spatial': 1.0 + nrm(ks[14], (DEPTH, C_HEADS, CHUNK), 0.01),
        'ln1_g': 1.0 + nrm(ks[15], (DEPTH, D_MODEL), 0.01),
        'ln1_b': nrm(ks[16], (DEPTH, D_MODEL), 0.01),
        'w_ffn_in': nrm(ks[17], (DEPTH, D_MODEL, 2 * D_FF), D_MODEL ** -0.5),
        'w_ffn_out': nrm(ks[18], (DEPTH, D_FF, D_MODEL), BETA * D_FF ** -0.5),
        'ln2_g': 1.0 + nrm(ks[19], (DEPTH, D_MODEL), 0.01),
        'ln2_b': nrm(ks[20], (DEPTH, D_MODEL), 0.01),
    }


def reference(x, c, ctx, c_ctx, w_ada, b_ada, w_in, w_out, attn_sink, w_fourier, b_fourier,
              sgu_ln_g, sgu_ln_b, w_spatial, b_spatial, ln1_g, ln1_b, w_ffn_in, w_ffn_out,
              ln2_g, ln2_b):
    rope = _axial_rope_tables(x.shape[1])
    xc = ctx
    for l in range(DEPTH):
        x, xc = _layer(x, xc, c, c_ctx, rope, w_ada[l], b_ada[l], w_in[l], w_out[l], attn_sink[l],
                       w_fourier[l], b_fourier[l], sgu_ln_g[l], sgu_ln_b[l], w_spatial[l],
                       b_spatial[l], ln1_g[l], ln1_b[l], w_ffn_in[l], w_ffn_out[l], ln2_g[l],
                       ln2_b[l], l == DEPTH - 1)
    return x
```

```cpp
#include <hip/hip_runtime.h>
#include <hip/hip_cooperative_groups.h>
#include <cstdio>
#include <cstdint>
#define LAS __attribute__((address_space(3)))
namespace pg8 {
#define PG8_LAS __attribute__((address_space(3)))
typedef unsigned short bf16_t;
typedef short bf16x8 __attribute__((ext_vector_type(8)));
typedef float f32x4 __attribute__((ext_vector_type(4)));
typedef unsigned u32x4 __attribute__((ext_vector_type(4)));
constexpr int BM = 256, BK = 64, HALF = 128, HTB = HALF * BK * 2  , STAGE_BYTES = 8 * HTB, NXCD = 8, WGM = 8;

__host__ __device__ __forceinline__ int lds_byte(int r, int c) { const int st = (r >> 4) * 2 + (c >> 5), rr = r & 15, cc = c & 31, ob = rr * 64 + cc * 2; return st * 1024 + (ob ^ (((ob >> 9) & 1) << 5)); }
__host__ __device__ __forceinline__ void stage_rc(int b, int& R, int& C) { const int st = b / 1024, sb = b % 1024, swz = sb ^ (((sb >> 9) & 1) << 5); R = (st >> 1) * 16 + swz / 64; C = (st & 1) * 32 + (swz % 64) / 2; }
__host__ __device__ __forceinline__ int perm32(int rho) { const int n = rho >> 4, i = rho & 15; return 8 * (i >> 2) + 4 * n + (i & 3); }

struct Unit { int pm, pn; };
struct Gemm { const bf16_t* A; const bf16_t* Bt; int M, N, K; };

struct StaticOrder {
    int nM, nN, nwg, G, c;
    __host__ __device__ void init(int M, int N, int G_, int c_) { nM = M / BM; nN = N / BM; nwg = nM * nN; G = G_; c = c_; }
    __host__ __device__ bool next(int i, Unit& u) const {
        const long L = (long)i * G + c; if (L >= nwg) return false;
        int wgid = (int)L; { const int q = nwg / NXCD, r = nwg % NXCD, xcd = wgid % NXCD, off = wgid / NXCD; wgid = (xcd < r ? xcd * (q + 1) : r * (q + 1) + (xcd - r) * q) + off; }
        const int nig = WGM * nN, gid = wgid / nig, fm = gid * WGM, gsz = (nM - fm) < WGM ? (nM - fm) : WGM;
        u.pm = fm + ((wgid % nig) % gsz); u.pn = (wgid % nig) / gsz; return true;
    }
    __device__ __forceinline__ void a_ready(const Unit&) const {}
    __device__ __forceinline__ void done(const Unit&) const {}
};

__device__ __forceinline__ unsigned cvt_pk_bf16(float lo, float hi) { unsigned r; asm volatile("v_cvt_pk_bf16_f32 %0, %1, %2" : "=v"(r) : "v"(lo), "v"(hi)); return r; }
typedef float f32x2 __attribute__((ext_vector_type(2)));
template <class Epi, class Sched, bool ALIGN_EPI = false, bool SP2 = false>
__device__ __forceinline__ void gemm_phase(PG8_LAS unsigned char* lds, const Gemm g, const Sched& S, const Epi& E) {
    const int tid = threadIdx.x, wid = __builtin_amdgcn_readfirstlane(tid >> 6), lane = tid & 63, wr = wid >> 2, wc = wid & 3, fr = lane & 15, fq = lane >> 4;
    const int K = g.K, nt = K / BK;
    unsigned voffA[2], voffB[2];
#pragma unroll
    for (int i = 0; i < 2; ++i) { int R, C; stage_rc(tid * 16 + i * 8192, R, C); const int Rb = Epi::PERM ? ((R & ~31) + perm32(R & 31)) : R;
        voffA[i] = (unsigned)(R * K + C) * 2u; voffB[i] = (unsigned)(Rb * K + C) * 2u; }
    const size_t kstep = (size_t)(BK * 2);
    const size_t hstep = (size_t)HALF * K * 2;
    const size_t tstep = 2 * hstep;
    const unsigned ldsw = (unsigned)wid * 1024u;
    const int aoff = lds_byte(wr * 64 + fr, fq * 8), boff = lds_byte(wc * 32 + fr, fq * 8);
#define PG8_SA(b, h) (((b) * 2 + (h)) * HTB)
#define PG8_SB(b, h) ((4 + (b) * 2 + (h)) * HTB)
#define PG8_STAGE(bufoff, gbase, voff) do { _Pragma("unroll") for (int _i = 0; _i < 2; ++_i) \
        __builtin_amdgcn_global_load_lds((const unsigned*)((const char*)(gbase) + (voff)[_i]), (PG8_LAS unsigned*)(lds + (bufoff) + ldsw + _i * 8192), 16, 0, 0); } while (0)
#define PG8_LDA(dst, b, h) do { _Pragma("unroll") for (int m = 0; m < 4; ++m) _Pragma("unroll") for (int k = 0; k < 2; ++k) dst[m][k] = *(const PG8_LAS bf16x8*)(lds + PG8_SA(b, h) + aoff + m * 2048 + k * 1024); } while (0)
#define PG8_LDB(dst, b, h) do { _Pragma("unroll") for (int n = 0; n < 2; ++n) _Pragma("unroll") for (int k = 0; k < 2; ++k) dst[n][k] = *(const PG8_LAS bf16x8*)(lds + PG8_SB(b, h) + boff + n * 2048 + k * 1024); } while (0)
#define PG8_MMA(ai, bj, At, Bt) do { __builtin_amdgcn_s_setprio(1); _Pragma("unroll") for (int m = 0; m < 4; ++m) _Pragma("unroll") for (int n = 0; n < 2; ++n) _Pragma("unroll") for (int k = 0; k < 2; ++k) \
        acc[ai][bj][m][n] = __builtin_amdgcn_mfma_f32_16x16x32_bf16(Bt[n][k], At[m][k], acc[ai][bj][m][n], 0, 0, 0); __builtin_amdgcn_s_setprio(0); } while (0)
#define PG8_WAIT_V(n) asm volatile("s_waitcnt vmcnt(" #n ")" ::: "memory")
#define PG8_WAIT_L(n) asm volatile("s_waitcnt lgkmcnt(" #n ")" ::: "memory")
#define PG8_BAR __builtin_amdgcn_s_barrier()
#define PG8_SCHED __builtin_amdgcn_sched_barrier(0)
    Unit cur, nxt; int ui = 0;
    if (!S.next(0, cur)) return;
    f32x4 acc[2][2][4][2];
#pragma unroll
    for (int a = 0; a < 2; ++a)
#pragma unroll
        for (int b = 0; b < 2; ++b)
#pragma unroll
            for (int m = 0; m < 4; ++m)
#pragma unroll
                for (int n = 0; n < 2; ++n) acc[a][b][m][n] = (f32x4){0.f, 0.f, 0.f, 0.f};
    bf16x8 At[4][2], B0[2][2], B1[2][2];
    const char* cA = (const char*)g.A + (size_t)cur.pm * tstep; const char* cB = (const char*)g.Bt + (size_t)cur.pn * tstep;
    S.a_ready(cur);
    if constexpr (SP2) {
        PG8_STAGE(PG8_SB(0, 0), cB, voffB); PG8_STAGE(PG8_SB(0, 1), cB + hstep, voffB); PG8_STAGE(PG8_SA(0, 0), cA, voffA); PG8_STAGE(PG8_SA(0, 1), cA + hstep, voffA);
        if (wr == 1) PG8_BAR;
        PG8_WAIT_V(2); PG8_BAR;
        PG8_STAGE(PG8_SB(1, 0), cB + kstep, voffB); PG8_STAGE(PG8_SA(1, 0), cA + kstep, voffA); PG8_STAGE(PG8_SB(1, 1), cB + hstep + kstep, voffB);
        PG8_WAIT_V(6); PG8_BAR;
    } else {
        PG8_STAGE(PG8_SB(0, 0), cB, voffB); PG8_STAGE(PG8_SA(0, 0), cA, voffA); PG8_STAGE(PG8_SB(0, 1), cB + hstep, voffB); PG8_STAGE(PG8_SA(0, 1), cA + hstep, voffA);
        if (wr == 1) PG8_BAR;
        PG8_WAIT_V(4); PG8_BAR;
        PG8_STAGE(PG8_SB(1, 0), cB + kstep, voffB); PG8_STAGE(PG8_SA(1, 0), cA + kstep, voffA); PG8_STAGE(PG8_SB(1, 1), cB + hstep + kstep, voffB);
        PG8_WAIT_V(6); PG8_BAR;
    }
    for (;;) {
        const bool has_next = S.next(ui + 1, nxt);
        const char* nA = has_next ? (const char*)g.A + (size_t)nxt.pm * tstep : cA; const char* nB = has_next ? (const char*)g.Bt + (size_t)nxt.pn * tstep : cB;
        for (int t = 0; t < nt; t += 2) {
            const bool last = (t == nt - 2);
            const char* a1 = cA + (size_t)(t + 1) * kstep;
            const char* a2 = last ? nA : cA + (size_t)(t + 2) * kstep; const char* b2 = last ? nB : cB + (size_t)(t + 2) * kstep;
            const char* a3 = a2 + kstep; const char* b3 = b2 + kstep;
            if (last && has_next) S.a_ready(nxt);
            if constexpr (SP2) {
            PG8_LDB(B0, 0, 0); PG8_LDB(B1, 0, 1); PG8_SCHED; PG8_LDA(At, 0, 0); PG8_STAGE(PG8_SA(1, 1), a1 + hstep, voffA);
            PG8_WAIT_V(8); PG8_WAIT_L(0); PG8_BAR; PG8_MMA(0, 0, At, B0); PG8_MMA(0, 1, At, B1); PG8_BAR; PG8_SCHED;
            PG8_LDA(At, 0, 1); PG8_STAGE(PG8_SB(0, 0), b2, voffB); PG8_STAGE(PG8_SB(0, 1), b2 + hstep, voffB); PG8_STAGE(PG8_SA(0, 0), a2, voffA);
            PG8_WAIT_V(8); PG8_WAIT_L(0); PG8_BAR; PG8_MMA(1, 0, At, B0); PG8_MMA(1, 1, At, B1); PG8_BAR; PG8_SCHED;
            PG8_LDB(B0, 1, 0); PG8_LDB(B1, 1, 1); PG8_SCHED; PG8_LDA(At, 1, 0); PG8_STAGE(PG8_SA(0, 1), a2 + hstep, voffA);
            PG8_WAIT_V(8); PG8_WAIT_L(0); PG8_BAR; PG8_MMA(0, 0, At, B0); PG8_MMA(0, 1, At, B1); PG8_BAR; PG8_SCHED;
            PG8_LDA(At, 1, 1); PG8_STAGE(PG8_SB(1, 0), b3, voffB); PG8_STAGE(PG8_SB(1, 1), b3 + hstep, voffB); PG8_STAGE(PG8_SA(1, 0), a3, voffA);
            PG8_WAIT_V(8); PG8_WAIT_L(0); PG8_BAR; PG8_MMA(1, 0, At, B0); PG8_MMA(1, 1, At, B1); PG8_BAR; PG8_SCHED;
            } else {
            PG8_LDB(B0, 0, 0); PG8_SCHED; PG8_LDA(At, 0, 0); PG8_STAGE(PG8_SA(1, 1), a1 + hstep, voffA);
            PG8_WAIT_L(8); PG8_BAR; PG8_WAIT_L(0); PG8_MMA(0, 0, At, B0); PG8_BAR; PG8_SCHED;
            PG8_LDB(B1, 0, 1); PG8_STAGE(PG8_SB(0, 0), b2, voffB);
            PG8_BAR; PG8_WAIT_L(0); PG8_MMA(0, 1, At, B1); PG8_BAR;
            PG8_LDA(At, 0, 1); PG8_STAGE(PG8_SA(0, 0), a2, voffA);
            PG8_BAR; PG8_WAIT_L(0); PG8_MMA(1, 0, At, B0); PG8_BAR; PG8_SCHED;
            PG8_STAGE(PG8_SB(0, 1), b2 + hstep, voffB);
            PG8_WAIT_V(6); PG8_BAR; PG8_MMA(1, 1, At, B1); PG8_BAR;
            PG8_LDB(B0, 1, 0); PG8_SCHED; PG8_LDA(At, 1, 0); PG8_STAGE(PG8_SA(0, 1), a2 + hstep, voffA);
            PG8_WAIT_L(8); PG8_BAR; PG8_WAIT_L(0); PG8_MMA(0, 0, At, B0); PG8_BAR; PG8_SCHED;
            PG8_LDB(B1, 1, 1); PG8_STAGE(PG8_SB(1, 0), b3, voffB);
            PG8_BAR; PG8_WAIT_L(0); PG8_MMA(0, 1, At, B1); PG8_BAR;
            PG8_LDA(At, 1, 1); PG8_STAGE(PG8_SA(1, 0), a3, voffA);
            PG8_BAR; PG8_WAIT_L(0); PG8_MMA(1, 0, At, B0); PG8_BAR; PG8_SCHED;
            PG8_STAGE(PG8_SB(1, 1), b3 + hstep, voffB);
            PG8_WAIT_V(6); PG8_BAR; PG8_MMA(1, 1, At, B1); PG8_BAR;
            }
        }
        if constexpr (ALIGN_EPI) { if (wr == 0) PG8_BAR; }
        if constexpr (!Epi::AFTER_DRAIN) { E(acc, cur, wr, wc, fr, fq); S.done(cur); }
        if (!has_next) break;
#pragma unroll
        for (int a = 0; a < 2; ++a)
#pragma unroll
            for (int b = 0; b < 2; ++b)
#pragma unroll
                for (int m = 0; m < 4; ++m)
#pragma unroll
                    for (int n = 0; n < 2; ++n) acc[a][b][m][n] = (f32x4){0.f, 0.f, 0.f, 0.f};
        cur = nxt; cA = nA; cB = nB; ++ui;
        if constexpr (ALIGN_EPI) { if (wr == 1) PG8_BAR; }
    }
    PG8_WAIT_V(0);
    if constexpr (!ALIGN_EPI) { if (wr == 0) PG8_BAR; }
    PG8_BAR;
    if constexpr (Epi::AFTER_DRAIN) { E.fused(acc, cur, wr, wc, fr, fq, lds, wid, lane); S.done(cur); }
#undef PG8_SA
#undef PG8_SB
#undef PG8_STAGE
#undef PG8_LDA
#undef PG8_LDB
#undef PG8_MMA
#undef PG8_WAIT_V
#undef PG8_WAIT_L
#undef PG8_BAR
#undef PG8_SCHED
}
}

namespace pg8 {
__device__ __forceinline__ float fast_sigmoid(float z) { return __builtin_amdgcn_rcpf(1.0f + __builtin_amdgcn_exp2f(-1.44269504089f * z)); }
__device__ __forceinline__ float gelu_tanh(float x) { const float z = 1.5957691216f * (x + 0.044715f * x * x * x); return x * fast_sigmoid(z); }
__device__ __forceinline__ float silu_f(float x) { return x * fast_sigmoid(x); }
typedef unsigned u32x2 __attribute__((ext_vector_type(2)));

struct EpiIn {
    static constexpr bool PERM = false, AFTER_DRAIN = false;
    bf16_t* Q; const float* rope;
    static constexpr size_t OK_ = (size_t)16640 * 512, OV_ = OK_ + (size_t)16640 * 128, OF_ = OV_ + (size_t)16640 * 128, OU_ = OF_ + (size_t)16640 * 256;
    __device__ __forceinline__ void operator()(const f32x4 (&acc)[2][2][4][2], const Unit& u, int wr, int wc, int fr, int fq) const {
        const int pn = u.pn;
        const int rbase = u.pm * BM + wr * 64 + fr;
        if (pn <= 2) {
#pragma unroll
            for (int ai = 0; ai < 2; ++ai)
#pragma unroll
                for (int m = 0; m < 4; ++m) {
                    const int row = rbase + ai * HALF + m * 16;
                    const bool latent = row < 16384;
                    const int pos = latent ? ((wc & 1) ? (row & 63) : (row >> 6)) : 0;
                    const f32x4 cs = *(const f32x4*)(rope + pos * 16 + 4 * fq);
                    const f32x4 sn = *(const f32x4*)(rope + 4096 + pos * 16 + 4 * fq);
#pragma unroll
                    for (int bj = 0; bj < 2; ++bj) {
                        const f32x4 x1 = acc[ai][bj][m][0], x2 = acc[ai][bj][m][1];
                        f32x4 o1 = x1, o2 = x2;
                        const bool isv = (pn == 2 && bj == 1);
                        if (!isv && latent) { o1 = x1 * cs - x2 * sn; o2 = x1 * sn + x2 * cs; }
                        bf16_t* dst;
                        if (pn < 2) { o1 = o1 * 0.18033688011f; o2 = o2 * 0.18033688011f; dst = Q + (size_t)row * 512 + pn * 256 + bj * HALF + wc * 32 + 4 * fq; }
                        else dst = Q + (bj == 0 ? OK_ : OV_) + (size_t)row * 128 + wc * 32 + 4 * fq;
                        u32x2 w0, w1; w0.x = cvt_pk_bf16(o1[0], o1[1]); w0.y = cvt_pk_bf16(o1[2], o1[3]); w1.x = cvt_pk_bf16(o2[0], o2[1]); w1.y = cvt_pk_bf16(o2[2], o2[3]);
                        *(u32x2*)dst = w0; *(u32x2*)(dst + 16) = w1;
                    }
                }
        } else {
            bf16_t* dstb = Q + OF_ + (size_t)(pn - 3) * ((size_t)16640 * 256);
            const bool act = pn >= 4;
#pragma unroll
            for (int ai = 0; ai < 2; ++ai)
#pragma unroll
                for (int m = 0; m < 4; ++m) {
                    const int row = rbase + ai * HALF + m * 16;
#pragma unroll
                    for (int bj = 0; bj < 2; ++bj)
#pragma unroll
                        for (int n = 0; n < 2; ++n) {
                            f32x4 v = acc[ai][bj][m][n];
                            if (act) { v[0] = gelu_tanh(v[0]); v[1] = gelu_tanh(v[1]); v[2] = gelu_tanh(v[2]); v[3] = gelu_tanh(v[3]); }
                            u32x2 w; w.x = cvt_pk_bf16(v[0], v[1]); w.y = cvt_pk_bf16(v[2], v[3]);
                            *(u32x2*)(dstb + (size_t)row * 256 + bj * HALF + wc * 32 + 16 * n + 4 * fq) = w;
                        }
                }
        }
    }
};

struct EpiSwiglu {
    static constexpr bool PERM = true, AFTER_DRAIN = false;
    bf16_t* O; int ldc;
    __device__ __forceinline__ void operator()(const f32x4 (&acc)[2][2][4][2], const Unit& u, int wr, int wc, int fr, int fq) const {
        const int row0 = u.pm * BM + wr * 64 + fr, col0 = u.pn * HALF + wc * 32 + 8 * fq;
#pragma unroll
        for (int ai = 0; ai < 2; ++ai)
#pragma unroll
            for (int m = 0; m < 4; ++m) {
                bf16_t* rowp = O + (size_t)(row0 + ai * HALF + m * 16) * ldc + col0;
                f32x4 h0, h1;
#pragma unroll
                for (int j = 0; j < 4; ++j) { h0[j] = silu_f(acc[ai][0][m][0][j]) * acc[ai][1][m][0][j]; h1[j] = silu_f(acc[ai][0][m][1][j]) * acc[ai][1][m][1][j]; }
                u32x4 w; w.x = cvt_pk_bf16(h0[0], h0[1]); w.y = cvt_pk_bf16(h0[2], h0[3]); w.z = cvt_pk_bf16(h1[0], h1[1]); w.w = cvt_pk_bf16(h1[2], h1[3]);
                *(u32x4*)rowp = w;
            }
    }
};

struct EpiRes {
    static constexpr bool PERM = false, AFTER_DRAIN = false;
    const float* res; float* out; const float* gate; const float* res_c; float* out_c; const float* gate_c; float alpha;
    __device__ __forceinline__ void operator()(const f32x4 (&acc)[2][2][4][2], const Unit& u, int wr, int wc, int fr, int fq) const {
        const bool isc = (u.pm == 64);
        const float* rp = isc ? res_c : res; float* op = isc ? out_c : out; const float* gp = isc ? gate_c : gate;
        const int row0 = (isc ? 0 : u.pm * BM) + wr * 64 + fr, col0 = u.pn * BM + wc * 32 + 4 * fq;
        f32x4 gv[2][2];
#pragma unroll
        for (int bj = 0; bj < 2; ++bj)
#pragma unroll
            for (int n = 0; n < 2; ++n) gv[bj][n] = *(const f32x4*)(gp + col0 + bj * HALF + n * 16);
#pragma unroll
        for (int ai = 0; ai < 2; ++ai)
#pragma unroll
            for (int m = 0; m < 4; ++m) {
                const size_t off = (size_t)(row0 + ai * HALF + m * 16) * 1024 + col0;
#pragma unroll
                for (int bj = 0; bj < 2; ++bj)
#pragma unroll
                    for (int n = 0; n < 2; ++n) {
                        const f32x4 r = *(const f32x4*)(rp + off + bj * HALF + n * 16);
                        *(f32x4*)(op + off + bj * HALF + n * 16) = r * alpha + gv[bj][n] * acc[ai][bj][m][n];
                    }
            }
    }
};

struct OrderX {
    StaticOrder so; int extra, xpn;
    __device__ void init(int M, int N, int G, int c, int extra_, int xpn_) { so.init(M, N, G, c); extra = extra_; xpn = xpn_; }
    __device__ bool next(int i, Unit& u) const {
        if (so.next(i, u)) return true;
        const long L = (long)i * so.G + so.c;
        if (extra && L == so.nwg) { u.pm = 64; u.pn = xpn; return true; }
        return false;
    }
    __device__ __forceinline__ void a_ready(const Unit&) const {}
    __device__ __forceinline__ void done(const Unit&) const {}
};
}

namespace cg = cooperative_groups;
typedef unsigned short bf16;
typedef short bf16x8 __attribute__((ext_vector_type(8)));
typedef short s16x4 __attribute__((ext_vector_type(4)));
typedef float f32x4 __attribute__((ext_vector_type(4)));
typedef unsigned u32x4 __attribute__((ext_vector_type(4)));
typedef unsigned u32x2 __attribute__((ext_vector_type(2)));
#define MFMA16(a, b, c) __builtin_amdgcn_mfma_f32_16x16x32_bf16((a), (b), (c), 0, 0, 0)

constexpr int NTOK = 16384, NCTX = 256, MROWS = NTOK + NCTX, DM = 1024, DFF = 2816, DIN = 1536;
constexpr float ALPHA_DN = 1.41421356237f, LN_EPS = 1e-6f, LOG2E = 1.44269504089f;
constexpr size_t MiB = 1u << 20;
constexpr size_t WS_W1 = 1 * MiB;
constexpr size_t WS_W2 = WS_W1 + 65536;
constexpr size_t WS_WC = WS_W2 + 131072;
constexpr size_t WS_ROPE = WS_WC + 262144;
constexpr size_t WS_TW = WS_ROPE + 32768;
constexpr size_t WS_WS = WS_TW + 131072;
constexpr size_t WS_WFC = WS_WS + 262144;
constexpr size_t WS_MOD = 3 * MiB;
constexpr size_t WS_WIN = 4 * MiB, WS_WOUT = 10 * MiB, WS_WF1 = 14 * MiB, WS_WF2 = 36 * MiB, WS_XC = 47 * MiB, WS_H = 48 * MiB, WS_ACT = 81 * MiB;
constexpr size_t WS_Q = WS_ACT, WS_K = WS_Q + (size_t)MROWS * 512 * 2, WS_V = WS_K + (size_t)MROWS * 128 * 2, WS_F = WS_V + (size_t)MROWS * 128 * 2,
                 WS_U = WS_F + (size_t)MROWS * 256 * 2, WS_G = WS_U + (size_t)MROWS * 256 * 2, WS_O = WS_G + (size_t)MROWS * 256 * 2,
                 WS_Y = WS_O + (size_t)MROWS * 1024 * 2, WS_YEND = WS_Y + (size_t)128 * 128 * 2 * 256 * 2;
constexpr size_t WS_HMID = WS_ACT, WS_END = 200 * MiB;
static_assert(WS_WFC + 262144 <= WS_MOD && WS_YEND <= WS_END && WS_HMID + (size_t)MROWS * DFF * 2 <= WS_END && WS_H + (size_t)MROWS * DM * 2 <= WS_ACT, "ws map");
constexpr int LDS_BYTES = 147456;

__device__ __forceinline__ unsigned f2bf(float f) { unsigned u = __builtin_bit_cast(unsigned, f); return (u + 0x7fffu + ((u >> 16) & 1u)) >> 16; }
__device__ __forceinline__ unsigned pk2(float lo, float hi) { return f2bf(lo) | (f2bf(hi) << 16); }
__device__ __forceinline__ float bf2f(unsigned short b) { return __builtin_bit_cast(float, (unsigned)b << 16); }
__device__ __forceinline__ float wave_sum(float v) {
#pragma unroll
    for (int o = 1; o < 64; o <<= 1) v += __shfl_xor(v, o);
    return v;
}

struct Params { const float* in[21]; float* out; unsigned char* ws; };
typedef const __attribute__((address_space(4))) Params* KP;
__device__ __forceinline__ KP kparams() { KP k = (KP)__builtin_amdgcn_kernarg_segment_ptr(); asm volatile("" : "+s"(k)); return k; }
enum { I_X = 0, I_C, I_CTX, I_CCTX, I_WADA, I_BADA, I_WIN, I_WOUT, I_SINK, I_WFOUR, I_BFOUR, I_SLNG, I_SLNB, I_WSP, I_BSP, I_LN1G, I_LN1B, I_WF1, I_WF2, I_LN2G, I_LN2B };

__device__ __forceinline__ void transpose_item(const float* W, int K, int N, bf16* WT, int mode, LAS float* scr, int item, int lane) {
    const int nblk = N / 32, kb = item / nblk, nb = item % nblk, k0 = 64 * kb, n0 = 32 * nb;
    int r0 = n0;
    if (mode == 1) { r0 = (n0 < DFF) ? (256 * (n0 / 128) + (n0 % 128)) : (256 * ((n0 - DFF) / 128) + 128 + ((n0 - DFF) % 128)); }
#pragma unroll 8
    for (int i = 0; i < 32; ++i) { const int kk = 2 * i + (lane >> 5); scr[kk * 33 + (lane & 31)] = W[(size_t)(k0 + kk) * N + n0 + (lane & 31)]; }
    asm volatile("s_waitcnt lgkmcnt(0)" ::: "memory");
    const int c = lane & 7;
#pragma unroll
    for (int j = 0; j < 4; ++j) { const int n = (lane >> 3) + 8 * j; const LAS float* s = scr + (8 * c) * 33 + n;
        u32x4 o; o.x = pk2(s[0 * 33], s[1 * 33]); o.y = pk2(s[2 * 33], s[3 * 33]); o.z = pk2(s[4 * 33], s[5 * 33]); o.w = pk2(s[6 * 33], s[7 * 33]);
        *(u32x4*)(WT + (size_t)(r0 + n) * K + k0 + 8 * c) = o; }
    asm volatile("s_waitcnt lgkmcnt(0)" ::: "memory");
}

__device__ __forceinline__ void ada_item(LAS unsigned char* lds, KP p, int item) {
    LAS float* sc = (LAS float*)lds;
    LAS float* red = sc + 2048;
    const int tid = threadIdx.x, lane = tid & 63, w = tid >> 6;
    const int l = item / 96, j = item % 96;
    __syncthreads();
    for (int i = tid; i < 2048; i += 512) { const float v = (i < 1024) ? p->in[I_C][i] : p->in[I_CCTX][i - 1024]; sc[i] = v / (1.0f + __expf(-v)); }
    __syncthreads();
    const float* W = p->in[I_WADA] + (size_t)l * 1024 * 6144 + 64 * j + lane;
    float a0 = 0.f, a1 = 0.f;
#pragma unroll 8
    for (int k = 128 * w; k < 128 * w + 128; ++k) { const float wv = W[(size_t)k * 6144]; a0 += sc[k] * wv; a1 += sc[1024 + k] * wv; }
    red[(w * 2 + 0) * 64 + lane] = a0; red[(w * 2 + 1) * 64 + lane] = a1;
    __syncthreads();
    if (tid < 128) {
        const int v = tid >> 6; float s = 0.f;
#pragma unroll
        for (int ww = 0; ww < 8; ++ww) s += red[(ww * 2 + v) * 64 + lane];
        s += p->in[I_BADA][l * 6144 + 64 * j + lane];
        ((float*)(p->ws + WS_MOD))[(l * 2 + v) * 6144 + 64 * j + lane] = s;
    }
}

__device__ __forceinline__ void tables(KP p, int gtid, int gthreads) {
    bf16* W1 = (bf16*)(p->ws + WS_W1); bf16* W2 = (bf16*)(p->ws + WS_W2); bf16* WC = (bf16*)(p->ws + WS_WC);
    float* ROPE = (float*)(p->ws + WS_ROPE); float* TW = (float*)(p->ws + WS_TW); bf16* WSb = (bf16*)(p->ws + WS_WS); bf16* WFC = (bf16*)(p->ws + WS_WFC);
    for (int i = gtid; i < 256 * 128; i += gthreads) { const int row = i >> 7, n1 = i & 127, part = row >> 7, k1 = row & 127; const float s = __builtin_amdgcn_sinf(0.5f * ((float)((k1 * n1) & 127) * (1.0f / 64.0f))), c = __builtin_amdgcn_cosf(0.5f * ((float)((k1 * n1) & 127) * (1.0f / 64.0f))); W1[i] = (bf16)f2bf(part ? -s : c); }
    for (int i = gtid; i < 256 * 256; i += gthreads) { const int row = i >> 8, kap = i & 255, pp = row >> 7, k2 = row & 127, part = kap >> 7, n2 = kap & 127; const float s = __builtin_amdgcn_sinf(0.5f * ((float)((k2 * n2) & 127) * (1.0f / 64.0f))), c = __builtin_amdgcn_cosf(0.5f * ((float)((k2 * n2) & 127) * (1.0f / 64.0f)));
        const float v = (pp == 0) ? (part == 0 ? c : s) : (part == 0 ? -s : c); W2[i] = (bf16)f2bf(v); }
    for (int i = gtid; i < 512 * 256; i += gthreads) { const int row = i >> 8, n = i & 255, part = row >> 8, k = row & 255; const float s = __builtin_amdgcn_sinf(0.5f * ((float)((k * n) & 255) * (1.0f / 128.0f))), c = __builtin_amdgcn_cosf(0.5f * ((float)((k * n) & 255) * (1.0f / 128.0f))); WC[i] = (bf16)f2bf(part ? -s : c); }
    for (int i = gtid; i < 256 * 16; i += gthreads) { const int pos = i >> 4, fi = i & 15; const float fr = __builtin_amdgcn_exp2f(-(float)(2 * fi) * (13.287712379549449f / 32.0f)); const float ang = (float)pos * fr; float t = ang * 0.15915494309189535f; t -= rintf(t); ROPE[i] = __builtin_amdgcn_cosf(t); ROPE[4096 + i] = __builtin_amdgcn_sinf(t); }
    for (int i = gtid; i < 16384; i += gthreads) { const float s = __builtin_amdgcn_sinf(0.5f * ((float)i * (1.0f / 8192.0f))), c = __builtin_amdgcn_cosf(0.5f * ((float)i * (1.0f / 8192.0f))); TW[2 * i] = c; TW[2 * i + 1] = s; }
    for (int i = gtid; i < 2 * 4 * 128 * 128; i += gthreads) WSb[i] = (bf16)f2bf(p->in[I_WSP][i]);
    for (int i = gtid; i < 2 * 2 * 4 * 64 * 128; i += gthreads) {
        const int K = i & 127, d = (i >> 7) & 63, g = (i >> 13) & 3, v = (i >> 15) & 1, l = i >> 16, part = K >> 6, cc = K & 63;
        const float* wf = p->in[I_WFOUR] + ((size_t)(l * 4 + g) * 64) * 64 + d; float acc = 0.f;
        for (int m = 0; m < 64; ++m) { const float s = __builtin_amdgcn_sinf(0.5f * ((float)((m * cc) & 63) * (1.0f / 32.0f))), c = __builtin_amdgcn_cosf(0.5f * ((float)((m * cc) & 63) * (1.0f / 32.0f))); acc += (part ? s : c) * wf[m * 64]; }
        WFC[i] = (bf16)f2bf(acc * (v ? (1.0f / 128.0f) : (1.0f / 1024.0f)));
    }
}

__device__ __forceinline__ void ln_row(const float* in, float* out, const float* ga, const float* be, bf16* hrow, const float* sh, const float* sc, int lane) {
    f32x4 v[4];
#pragma unroll
    for (int j = 0; j < 4; ++j) v[j] = ((const f32x4*)in)[lane + 64 * j];
    if (ga) {
        float s = 0.f;
#pragma unroll
        for (int j = 0; j < 4; ++j) s += (v[j][0] + v[j][1]) + (v[j][2] + v[j][3]);
        const float mean = wave_sum(s) * (1.0f / DM); float q = 0.f;
#pragma unroll
        for (int j = 0; j < 4; ++j) { v[j] = v[j] - mean; q += (v[j][0] * v[j][0] + v[j][1] * v[j][1]) + (v[j][2] * v[j][2] + v[j][3] * v[j][3]); }
        const float rstd = 1.0f / sqrtf(wave_sum(q) * (1.0f / DM) + LN_EPS);
#pragma unroll
        for (int j = 0; j < 4; ++j) { const f32x4 g4 = ((const f32x4*)ga)[lane + 64 * j], b4 = ((const f32x4*)be)[lane + 64 * j]; v[j] = v[j] * rstd * g4 + b4; ((f32x4*)out)[lane + 64 * j] = v[j]; }
    }
    if (hrow) {
        float s = 0.f;
#pragma unroll
        for (int j = 0; j < 4; ++j) s += (v[j][0] + v[j][1]) + (v[j][2] + v[j][3]);
        const float mean = wave_sum(s) * (1.0f / DM); float q = 0.f;
#pragma unroll
        for (int j = 0; j < 4; ++j) { v[j] = v[j] - mean; q += (v[j][0] * v[j][0] + v[j][1] * v[j][1]) + (v[j][2] * v[j][2] + v[j][3] * v[j][3]); }
        const float rstd = 1.0f / sqrtf(wave_sum(q) * (1.0f / DM) + LN_EPS);
#pragma unroll
        for (int j = 0; j < 4; ++j) { const f32x4 s4 = ((const f32x4*)sh)[lane + 64 * j], c4 = ((const f32x4*)sc)[lane + 64 * j]; const f32x4 h = v[j] * rstd * (c4 + 1.0f) + s4;
            u32x2 w; w.x = pk2(h[0], h[1]); w.y = pk2(h[2], h[3]); ((u32x2*)hrow)[lane + 64 * j] = w; }
    }
}

__device__ __forceinline__ void attn_unit(LAS unsigned char* lds, const bf16* Q, const bf16* K, const bf16* V, bf16* O, const float* sink, int qrow0, int qpos0, int kvh, int wlo, int whi) {
    int tid = threadIdx.x; asm volatile("" : "+v"(tid));
    const int lane = tid & 63, w = tid >> 6, r16 = lane & 15, g = lane >> 4;
    LAS bf16* KS = (LAS bf16*)lds;
    LAS bf16* VT = (LAS bf16*)(lds + 64 * 72 * 2);
    const int hq = 4 * kvh + (w >> 1), qw = 64 * (w & 1);
    LAS bf16* QS = (LAS bf16*)(lds + 18432 + w * 9216);
    __syncthreads();
#pragma unroll 2
    for (int i = 0; i < 8; ++i) { const int idx = lane + 64 * i, qr = idx >> 3, ch = idx & 7;
        *(LAS u32x4*)(QS + qr * 72 + ch * 8) = *(const u32x4*)(Q + (size_t)(qrow0 + qw + qr) * 512 + hq * 64 + ch * 8); }
    f32x4 oacc[4][4];
#pragma unroll
    for (int a = 0; a < 4; ++a)
#pragma unroll
        for (int b = 0; b < 4; ++b) oacc[a][b] = (f32x4){0.f, 0.f, 0.f, 0.f};
    float mrun[4], lrun[4];
    const float sk = sink[hq] * LOG2E;
#pragma unroll
    for (int qt = 0; qt < 4; ++qt) { mrun[qt] = sk; lrun[qt] = (g == 0) ? 1.0f : 0.0f; }
    const int nwin = whi - wlo, ntiles = nwin + 4;
    const int lk = tid >> 3, lc = tid & 7;
    u32x4 kreg, vreg;
    { const int row = (0 < nwin ? wlo * 64 : NTOK) + lk; kreg = *(const u32x4*)(K + (size_t)row * 128 + kvh * 64 + lc * 8); vreg = *(const u32x4*)(V + (size_t)row * 128 + kvh * 64 + lc * 8); }
    for (int t = 0; t < ntiles; ++t) {
        __syncthreads();
        *(LAS u32x4*)(KS + lk * 72 + lc * 8) = kreg;
#pragma unroll
        for (int e = 0; e < 4; ++e) { const unsigned wv = vreg[e]; VT[(lc * 8 + 2 * e) * 72 + lk] = (bf16)(wv & 0xffffu); VT[(lc * 8 + 2 * e + 1) * 72 + lk] = (bf16)(wv >> 16); }
        __syncthreads();
        if (t + 1 < ntiles) { const int tn = t + 1; const int row = (tn < nwin ? (wlo + tn) * 64 : NTOK + (tn - nwin) * 64) + lk;
            kreg = *(const u32x4*)(K + (size_t)row * 128 + kvh * 64 + lc * 8); vreg = *(const u32x4*)(V + (size_t)row * 128 + kvh * 64 + lc * 8); }
        const bool win = t < nwin; const int kpos0 = (wlo + t) * 64;
#pragma unroll
        for (int qh = 0; qh < 2; ++qh) {
            f32x4 s[4][2];
#pragma unroll
            for (int a = 0; a < 4; ++a)
#pragma unroll
                for (int b = 0; b < 2; ++b) s[a][b] = (f32x4){0.f, 0.f, 0.f, 0.f};
#pragma unroll
            for (int ks = 0; ks < 2; ++ks) {
                bf16x8 kf[4];
#pragma unroll
                for (int kt = 0; kt < 4; ++kt) kf[kt] = *(const LAS bf16x8*)(KS + (16 * kt + r16) * 72 + 32 * ks + 8 * g);
                bf16x8 qfr[2];
#pragma unroll
                for (int q2 = 0; q2 < 2; ++q2) qfr[q2] = *(const LAS bf16x8*)(QS + (16 * (2 * qh + q2) + r16) * 72 + 32 * ks + 8 * g);
#pragma unroll
                for (int kt = 0; kt < 4; ++kt)
#pragma unroll
                    for (int q2 = 0; q2 < 2; ++q2) s[kt][q2] = MFMA16(kf[kt], qfr[q2], s[kt][q2]);
            }
            if (win) {
#pragma unroll
                for (int kt = 0; kt < 4; ++kt)
#pragma unroll
                    for (int q2 = 0; q2 < 2; ++q2)
#pragma unroll
                        for (int j = 0; j < 4; ++j) { const int d = (kpos0 + 16 * kt + 4 * g + j) - (qpos0 + qw + 16 * (2 * qh + q2) + r16); if (d > 128 || d < -128) s[kt][q2][j] = -INFINITY; }
            }
#pragma unroll
            for (int q2 = 0; q2 < 2; ++q2) {
                const int qt = 2 * qh + q2;
                float mx = -INFINITY;
#pragma unroll
                for (int kt = 0; kt < 4; ++kt)
#pragma unroll
                    for (int j = 0; j < 4; ++j) mx = fmaxf(mx, s[kt][q2][j]);
                mx = fmaxf(mx, __shfl_xor(mx, 16)); mx = fmaxf(mx, __shfl_xor(mx, 32));
                const float mnew = fmaxf(mrun[qt], mx); const float alpha = __builtin_amdgcn_exp2f(mrun[qt] - mnew); mrun[qt] = mnew;
                float ps = 0.f;
#pragma unroll
                for (int kt = 0; kt < 4; ++kt)
#pragma unroll
                    for (int j = 0; j < 4; ++j) { const float pv = __builtin_amdgcn_exp2f(s[kt][q2][j] - mnew); s[kt][q2][j] = pv; ps += pv; }
                lrun[qt] = lrun[qt] * alpha + ps;
#pragma unroll
                for (int dt = 0; dt < 4; ++dt) oacc[dt][qt] = oacc[dt][qt] * alpha;
            }
#pragma unroll
            for (int kp = 0; kp < 2; ++kp) {
                bf16x8 pf[2];
#pragma unroll
                for (int q2 = 0; q2 < 2; ++q2) { u32x4 pw; pw.x = pk2(s[2 * kp][q2][0], s[2 * kp][q2][1]); pw.y = pk2(s[2 * kp][q2][2], s[2 * kp][q2][3]);
                    pw.z = pk2(s[2 * kp + 1][q2][0], s[2 * kp + 1][q2][1]); pw.w = pk2(s[2 * kp + 1][q2][2], s[2 * kp + 1][q2][3]); pf[q2] = __builtin_bit_cast(bf16x8, pw); }
#pragma unroll
                for (int dt = 0; dt < 4; ++dt) {
                    const s16x4 lo = *(const LAS s16x4*)(VT + (16 * dt + r16) * 72 + 32 * kp + 4 * g);
                    const s16x4 hi = *(const LAS s16x4*)(VT + (16 * dt + r16) * 72 + 32 * kp + 16 + 4 * g);
                    const bf16x8 vf = __builtin_shufflevector(lo, hi, 0, 1, 2, 3, 4, 5, 6, 7);
#pragma unroll
                    for (int q2 = 0; q2 < 2; ++q2) oacc[dt][2 * qh + q2] = MFMA16(vf, pf[q2], oacc[dt][2 * qh + q2]);
                }
            }
            __builtin_amdgcn_sched_barrier(0);
        }
    }
#pragma unroll
    for (int qt = 0; qt < 4; ++qt) {
        float l = lrun[qt]; l += __shfl_xor(l, 16); l += __shfl_xor(l, 32);
        const float inv = 1.0f / l;
        bf16* orow = O + (size_t)(qrow0 + qw + 16 * qt + r16) * 1024 + hq * 64 + 4 * g;
#pragma unroll
        for (int dt = 0; dt < 4; ++dt) { const f32x4 o = oacc[dt][qt] * inv; u32x2 wv; wv.x = pk2(o[0], o[1]); wv.y = pk2(o[2], o[3]); *(u32x2*)(orow + 16 * dt) = wv; }
    }
}

__device__ __forceinline__ void sgu_unit(LAS unsigned char* lds, const bf16* U, const bf16* G, bf16* O, const bf16* WSb, const float* bs, const float* lng, const float* lnb, int row0) {
    int tid = threadIdx.x; asm volatile("" : "+v"(tid));
    const int lane = tid & 63, w = tid >> 6, r16 = lane & 15, g = lane >> 4;
    LAS bf16* VT = (LAS bf16*)lds;
    __syncthreads();
    { const int q = tid >> 2, part = tid & 3;
#pragma unroll 1
      for (int h = 0; h < 4; ++h) {
        const u32x4 a = *(const u32x4*)(G + (size_t)(row0 + q) * 256 + h * 64 + part * 16), b = *(const u32x4*)(G + (size_t)(row0 + q) * 256 + h * 64 + part * 16 + 8);
        float x[16];
#pragma unroll
        for (int e = 0; e < 4; ++e) { x[2 * e] = bf2f((unsigned short)(a[e] & 0xffffu)); x[2 * e + 1] = bf2f((unsigned short)(a[e] >> 16)); x[8 + 2 * e] = bf2f((unsigned short)(b[e] & 0xffffu)); x[8 + 2 * e + 1] = bf2f((unsigned short)(b[e] >> 16)); }
        float s = 0.f;
#pragma unroll
        for (int e = 0; e < 16; ++e) s += x[e];
        s += __shfl_xor(s, 1); s += __shfl_xor(s, 2);
        const float mean = s * (1.0f / 64.0f); float qq = 0.f;
#pragma unroll
        for (int e = 0; e < 16; ++e) { x[e] -= mean; qq += x[e] * x[e]; }
        qq += __shfl_xor(qq, 1); qq += __shfl_xor(qq, 2);
        const float rstd = 1.0f / sqrtf(qq * (1.0f / 64.0f) + LN_EPS);
#pragma unroll
        for (int e = 0; e < 16; ++e) { const int dd = part * 16 + e; const float y = x[e] * rstd * lng[h * 64 + dd] + lnb[h * 64 + dd]; VT[(h * 64 + dd) * 136 + q] = (bf16)f2bf(y); }
      } }
    __syncthreads();
#pragma unroll 1
    for (int h = 0; h < 4; ++h) {
        f32x4 acc[4];
#pragma unroll
        for (int nt = 0; nt < 4; ++nt) acc[nt] = (f32x4){0.f, 0.f, 0.f, 0.f};
#pragma unroll
        for (int ks = 0; ks < 4; ++ks) {
            const bf16x8 af = *(const bf16x8*)(WSb + ((size_t)h * 128 + 16 * w + r16) * 128 + 32 * ks + 8 * g);
#pragma unroll
            for (int nt = 0; nt < 4; ++nt) { const bf16x8 bfr = *(const LAS bf16x8*)(VT + (h * 64 + 16 * nt + r16) * 136 + 32 * ks + 8 * g); acc[nt] = MFMA16(af, bfr, acc[nt]); }
        }
#pragma unroll
        for (int j = 0; j < 4; ++j) { const int pp = 16 * w + 4 * g + j; const float bias = bs[h * 128 + pp];
#pragma unroll
            for (int nt = 0; nt < 4; ++nt) { const int col = h * 64 + 16 * nt + r16; const float u = bf2f(U[(size_t)(row0 + pp) * 256 + col]); O[(size_t)(row0 + pp) * 1024 + 768 + col] = (bf16)f2bf(u * (acc[nt][j] + bias)); } }
    }
}

__device__ __forceinline__ void fft1_item(LAS unsigned char* lds, const bf16* F, bf16* Y, const bf16* W1, const float* TW, int n2, int hc) {
    int tid = threadIdx.x; asm volatile("" : "+v"(tid));
    const int lane = tid & 63, w = tid >> 6, r16 = lane & 15, g = lane >> 4;
    LAS bf16* FT = (LAS bf16*)lds;
    __syncthreads();
#pragma unroll 1
    for (int i = 0; i < 4; ++i) { const int idx = tid + 512 * i, n1 = idx >> 4, ch = idx & 15; const u32x4 v = *(const u32x4*)(F + (size_t)(128 * n1 + n2) * 256 + hc * 128 + ch * 8);
#pragma unroll
        for (int e = 0; e < 4; ++e) { FT[(ch * 8 + 2 * e) * 136 + n1] = (bf16)(v[e] & 0xffffu); FT[(ch * 8 + 2 * e + 1) * 136 + n1] = (bf16)(v[e] >> 16); } }
    __syncthreads();
    f32x4 ar[8], ai[8];
#pragma unroll
    for (int nt = 0; nt < 8; ++nt) { ar[nt] = (f32x4){0.f, 0.f, 0.f, 0.f}; ai[nt] = (f32x4){0.f, 0.f, 0.f, 0.f}; }
#pragma unroll
    for (int ks = 0; ks < 4; ++ks) {
        const bf16x8 a_re = *(const bf16x8*)(W1 + (size_t)(16 * w + r16) * 128 + 32 * ks + 8 * g), a_im = *(const bf16x8*)(W1 + (size_t)(128 + 16 * w + r16) * 128 + 32 * ks + 8 * g);
#pragma unroll
        for (int nt = 0; nt < 8; ++nt) { const bf16x8 bfr = *(const LAS bf16x8*)(FT + (16 * nt + r16) * 136 + 32 * ks + 8 * g); ar[nt] = MFMA16(a_re, bfr, ar[nt]); ai[nt] = MFMA16(a_im, bfr, ai[nt]); }
    }
#pragma unroll
    for (int j = 0; j < 4; ++j) { const int k1 = 16 * w + 4 * g + j; const int m = (n2 * k1) & 16383; const float tc = TW[2 * m], ts = TW[2 * m + 1];
        bf16* yrow = Y + ((size_t)(n2 * 128 + k1) * 2) * 256 + hc * 128 + r16;
#pragma unroll
        for (int nt = 0; nt < 8; ++nt) { const float yr = ar[nt][j] * tc + ai[nt][j] * ts, yi = ai[nt][j] * tc - ar[nt][j] * ts; yrow[16 * nt] = (bf16)f2bf(yr); yrow[256 + 16 * nt] = (bf16)f2bf(yi); } }
}

__device__ __forceinline__ void fft2_item(LAS unsigned char* lds, const bf16* Bsrc, int sA, int sB, const bf16* Amat, int re_row0, int im_row0, const bf16* Wfc, const float* bfour, bf16* O, int tok0, int tok_stride, int hc) {
    int tid = threadIdx.x; asm volatile("" : "+v"(tid));
    const int lane = tid & 63, w = tid >> 6, r16 = lane & 15, g = lane >> 4;
    LAS bf16* YT = (LAS bf16*)lds;
    __syncthreads();
#pragma unroll 2
    for (int i = 0; i < 8; ++i) { const int idx = tid + 512 * i, kap = idx >> 4, ch = idx & 15; const u32x4 v = *(const u32x4*)(Bsrc + (size_t)(kap >> 7) * sA + (size_t)(kap & 127) * sB + hc * 128 + ch * 8);
#pragma unroll
        for (int e = 0; e < 4; ++e) { YT[(ch * 8 + 2 * e) * 264 + kap] = (bf16)(v[e] & 0xffffu); YT[(ch * 8 + 2 * e + 1) * 264 + kap] = (bf16)(v[e] >> 16); } }
    __syncthreads();
    f32x4 xr[8], xi[8];
#pragma unroll
    for (int nt = 0; nt < 8; ++nt) { xr[nt] = (f32x4){0.f, 0.f, 0.f, 0.f}; xi[nt] = (f32x4){0.f, 0.f, 0.f, 0.f}; }
#pragma unroll 2
    for (int ks = 0; ks < 8; ++ks) {
        const bf16x8 a_re = *(const bf16x8*)(Amat + (size_t)(re_row0 + 16 * w + r16) * 256 + 32 * ks + 8 * g), a_im = *(const bf16x8*)(Amat + (size_t)(im_row0 + 16 * w + r16) * 256 + 32 * ks + 8 * g);
#pragma unroll
        for (int nt = 0; nt < 8; ++nt) { const bf16x8 bfr = *(const LAS bf16x8*)(YT + (16 * nt + r16) * 264 + 32 * ks + 8 * g); xr[nt] = MFMA16(a_re, bfr, xr[nt]); xi[nt] = MFMA16(a_im, bfr, xi[nt]); }
    }
    __syncthreads();
    LAS bf16* XT = YT;
#pragma unroll
    for (int nt = 0; nt < 8; ++nt)
#pragma unroll
        for (int j = 0; j < 4; ++j) { LAS bf16* xp = XT + (16 * w + 4 * g + j) * 264 + (nt >> 2) * 128 + 16 * (nt & 3) + r16; xp[0] = (bf16)f2bf(xr[nt][j]); xp[64] = (bf16)f2bf(xi[nt][j]); }
    __syncthreads();
#pragma unroll 1
    for (int gl = 0; gl < 2; ++gl) {
        const int gg = 2 * hc + gl;
        f32x4 acc[4];
#pragma unroll
        for (int nt = 0; nt < 4; ++nt) acc[nt] = (f32x4){0.f, 0.f, 0.f, 0.f};
#pragma unroll
        for (int ks = 0; ks < 4; ++ks) {
            const bf16x8 af = *(const LAS bf16x8*)(XT + (16 * w + r16) * 264 + gl * 128 + 32 * ks + 8 * g);
#pragma unroll
            for (int nt = 0; nt < 4; ++nt) { const bf16x8 bfr = *(const bf16x8*)(Wfc + ((size_t)gg * 64 + 16 * nt + r16) * 128 + 32 * ks + 8 * g); acc[nt] = MFMA16(af, bfr, acc[nt]); }
        }
#pragma unroll
        for (int j = 0; j < 4; ++j) { const size_t tok = (size_t)tok0 + (size_t)(16 * w + 4 * g + j) * tok_stride;
#pragma unroll
            for (int nt = 0; nt < 4; ++nt) { const int d = 16 * nt + r16; O[tok * 1024 + 512 + gg * 64 + d] = (bf16)f2bf(acc[nt][j] + bfour[gg * 64 + d]); } }
    }
}

#define WSP(T, off) ((T*)(ws + (off)))
__global__ void __launch_bounds__(512, 2) fwd_megakernel(Params p_unused) {
    extern __shared__ __attribute__((aligned(16))) unsigned char lds[];
    cg::grid_group grid = cg::this_grid();
    LAS unsigned char* L = (LAS unsigned char*)lds;

    {
        KP k = kparams();
        const int G = gridDim.x, bid = blockIdx.x;
        for (int it = bid; it < 192; it += G) ada_item(L, k, it);
        __syncthreads();
    }
    {
        KP k = kparams(); unsigned char* ws = k->ws;
        const int tid = threadIdx.x, lane = tid & 63, w = tid >> 6, G = gridDim.x, gw = blockIdx.x * 8 + w, NGW = G * 8;
        LAS float* scr = (LAS float*)(L + w * 16384);
        constexpr int I_IN = 16 * 48, I_OUT = 16 * 32, I_F1 = 16 * 176, I_F2 = 44 * 32, PER_L = I_IN + I_OUT + I_F1 + I_F2;
        for (int it = gw; it < 2 * PER_L; it += NGW) {
            const int l = it / PER_L; int r = it % PER_L;
            if (r < I_IN) { transpose_item(k->in[I_WIN] + (size_t)l * 1024 * 1536, 1024, 1536, WSP(bf16, WS_WIN) + (size_t)l * 1536 * 1024, 0, scr, r, lane); continue; } r -= I_IN;
            if (r < I_OUT) { transpose_item(k->in[I_WOUT] + (size_t)l * 1024 * 1024, 1024, 1024, WSP(bf16, WS_WOUT) + (size_t)l * 1024 * 1024, 0, scr, r, lane); continue; } r -= I_OUT;
            if (r < I_F1) { transpose_item(k->in[I_WF1] + (size_t)l * 1024 * 5632, 1024, 5632, WSP(bf16, WS_WF1) + (size_t)l * 5632 * 1024, 1, scr, r, lane); continue; } r -= I_F1;
            transpose_item(k->in[I_WF2] + (size_t)l * 2816 * 1024, 2816, 1024, WSP(bf16, WS_WF2) + (size_t)l * 1024 * 2816, 0, scr, r, lane);
        }
    }
    tables(kparams(), blockIdx.x * 512 + threadIdx.x, gridDim.x * 512);
    grid.sync();

    {
        KP k = kparams(); unsigned char* ws = k->ws;
        const int tid = threadIdx.x, lane = tid & 63, w = tid >> 6, gw = blockIdx.x * 8 + w, NGW = gridDim.x * 8;
        const float* MOD = WSP(const float, WS_MOD);
        for (int r = gw; r < MROWS; r += NGW) {
            const bool isc = r >= NTOK; const float* md = MOD + (isc ? 6144 : 0);
            const float* src = isc ? k->in[I_CTX] + (size_t)(r - NTOK) * DM : k->in[I_X] + (size_t)r * DM;
            ln_row(src, nullptr, nullptr, nullptr, WSP(bf16, WS_H) + (size_t)r * DM, md, md + 1024, lane);
        }
    }
    grid.sync();

#pragma unroll
    for (int l = 0; l < 2; ++l) {
        const bool first = (l == 0);
        const int Mrows = first ? MROWS : NTOK;
        {
            KP k = kparams(); unsigned char* ws = k->ws;
            pg8::Gemm g{WSP(bf16, WS_H), WSP(bf16, WS_WIN) + (size_t)l * 1536 * 1024, Mrows, DIN, DM};
            pg8::OrderX S; S.init(Mrows, DIN, gridDim.x, blockIdx.x, first ? 0 : 1, 2);
            pg8::EpiIn E{WSP(bf16, WS_Q), WSP(const float, WS_ROPE)};
            pg8::gemm_phase<pg8::EpiIn, pg8::OrderX, true, true>(L, g, S, E);
        }
        grid.sync();
        {
            const int n_att = first ? 260 : 256, n_f1 = 256, n_sgu = first ? 130 : 128;
            const int G = gridDim.x;
            for (int u = blockIdx.x; u < n_att + n_f1 + n_sgu; u += G) {
                KP k = kparams(); unsigned char* ws = k->ws;
                if (u < n_att) {
                    const float* sink = k->in[I_SINK] + l * 8;
                    if (u < 256) { const int nb = u >> 1, kvh = u & 1; const int wlo = (nb > 0 ? 2 * (nb - 1) : 0), whi = (2 * (nb + 2) < 256 ? 2 * (nb + 2) : 256);

#ifndef NO_ATT
                        attn_unit(L, WSP(bf16, WS_Q), WSP(bf16, WS_K), WSP(bf16, WS_V), WSP(bf16, WS_O), sink, 128 * nb, 128 * nb, kvh, wlo, whi);
#endif
 }
                    else { const int cu = u - 256;
#ifndef NO_ATT
 attn_unit(L, WSP(bf16, WS_Q), WSP(bf16, WS_K), WSP(bf16, WS_V), WSP(bf16, WS_O), sink, NTOK + 128 * (cu >> 1), 0, cu & 1, 0, 0);
#endif
 }
                } else if (u < n_att + n_f1) { const int it = u - n_att;
#ifndef NO_F1
 fft1_item(L, WSP(bf16, WS_F), WSP(bf16, WS_Y), WSP(const bf16, WS_W1), WSP(const float, WS_TW), it >> 1, it & 1);
#endif
 }
                else { const int ch = u - n_att - n_f1;

#ifndef NO_SGU
                    sgu_unit(L, WSP(bf16, WS_U), WSP(bf16, WS_G), WSP(bf16, WS_O), WSP(const bf16, WS_WS) + (size_t)l * 4 * 128 * 128, k->in[I_BSP] + l * 512, k->in[I_SLNG] + l * 256, k->in[I_SLNB] + l * 256, 128 * ch);
#endif
 }
            }
        }
        grid.sync();
        {
            const int n_f2 = first ? 260 : 256;
            const int G = gridDim.x;
            for (int u = blockIdx.x; u < n_f2; u += G) {
                KP k = kparams(); unsigned char* ws = k->ws;
                const bf16* wfc_l = WSP(const bf16, WS_WFC) + (size_t)(l * 2 + 0) * 4 * 64 * 128; const bf16* wfc_c = WSP(const bf16, WS_WFC) + (size_t)(l * 2 + 1) * 4 * 64 * 128;
                const float* bfo = k->in[I_BFOUR] + l * 256;
                if (u < 256) { const int k1 = u >> 1, hc = u & 1;
#ifndef NO_F2
 fft2_item(L, WSP(bf16, WS_Y) + (size_t)k1 * 512, 256, 65536, WSP(const bf16, WS_W2), 0, 128, wfc_l, bfo, WSP(bf16, WS_O), k1, 128, hc);
#endif
 }
                else { const int cu = u - 256, mh = cu >> 1, hc = cu & 1;
#ifndef NO_F2
 fft2_item(L, WSP(bf16, WS_F) + (size_t)NTOK * 256, 32768, 256, WSP(const bf16, WS_WC), 128 * mh, 256 + 128 * mh, wfc_c, bfo, WSP(bf16, WS_O), NTOK + 128 * mh, 1, hc);
#endif
 }
            }
        }
        grid.sync();
        {
            KP k = kparams(); unsigned char* ws = k->ws;
            const float* modl = WSP(const float, WS_MOD) + (size_t)l * 2 * 6144;
            pg8::Gemm g{WSP(bf16, WS_O), WSP(bf16, WS_WOUT) + (size_t)l * 1024 * 1024, Mrows, DM, DM};
            pg8::OrderX S; S.init(Mrows, DM, gridDim.x, blockIdx.x, 0, 0);
            pg8::EpiRes E{first ? k->in[I_X] : (const float*)k->out, k->out, modl + 2048, k->in[I_CTX], WSP(float, WS_XC), modl + 6144 + 2048, ALPHA_DN};
            pg8::gemm_phase<pg8::EpiRes, pg8::OrderX, true, true>(L, g, S, E);
        }
        grid.sync();
        {
            KP k = kparams(); unsigned char* ws = k->ws;
            const int tid = threadIdx.x, lane = tid & 63, w = tid >> 6, gw = blockIdx.x * 8 + w, NGW = gridDim.x * 8;
            const float* modl = WSP(const float, WS_MOD) + (size_t)l * 2 * 6144;
            for (int r = gw; r < Mrows; r += NGW) {
                const bool isc = r >= NTOK; const float* md = modl + (isc ? 6144 : 0);
                float* row = isc ? WSP(float, WS_XC) + (size_t)(r - NTOK) * DM : k->out + (size_t)r * DM;
                ln_row(row, row, k->in[I_LN1G] + l * DM, k->in[I_LN1B] + l * DM, WSP(bf16, WS_H) + (size_t)r * DM, md + 3072, md + 4096, lane);
            }
        }
        grid.sync();
        {
            KP k = kparams(); unsigned char* ws = k->ws;
            pg8::Gemm g{WSP(bf16, WS_H), WSP(bf16, WS_WF1) + (size_t)l * 5632 * 1024, Mrows, 2 * DFF, DM};
            pg8::OrderX S; S.init(Mrows, 2 * DFF, gridDim.x, blockIdx.x, 0, 0);
            pg8::EpiSwiglu E{WSP(bf16, WS_HMID), DFF};
            pg8::gemm_phase<pg8::EpiSwiglu, pg8::OrderX, true, true>(L, g, S, E);
        }
        grid.sync();
        {
            KP k = kparams(); unsigned char* ws = k->ws;
            const float* modl = WSP(const float, WS_MOD) + (size_t)l * 2 * 6144;
            pg8::Gemm g{WSP(bf16, WS_HMID), WSP(bf16, WS_WF2) + (size_t)l * 1024 * 2816, Mrows, DM, DFF};
            pg8::OrderX S; S.init(Mrows, DM, gridDim.x, blockIdx.x, 0, 0);
            pg8::EpiRes E{k->out, k->out, modl + 5120, WSP(float, WS_XC), WSP(float, WS_XC), modl + 6144 + 5120, ALPHA_DN};
            pg8::gemm_phase<pg8::EpiRes, pg8::OrderX, true, true>(L, g, S, E);
        }
        grid.sync();
        {
            KP k = kparams(); unsigned char* ws = k->ws;
            const int tid = threadIdx.x, lane = tid & 63, w = tid >> 6, gw = blockIdx.x * 8 + w, NGW = gridDim.x * 8;
            for (int r = gw; r < Mrows; r += NGW) {
                const bool isc = r >= NTOK; const float* mdn = WSP(const float, WS_MOD) + (size_t)2 * 6144 + (isc ? 6144 : 0);
                float* row = isc ? WSP(float, WS_XC) + (size_t)(r - NTOK) * DM : k->out + (size_t)r * DM;
                ln_row(row, row, k->in[I_LN2G] + l * DM, k->in[I_LN2B] + l * DM, first ? WSP(bf16, WS_H) + (size_t)r * DM : nullptr, mdn, mdn + 1024, lane);
            }
        }
        if (first) grid.sync();
    }
}

extern "C" void kernel_launch(void* const* d_in, const int* in_sizes, int n_in, void* d_out, int out_size, void* d_ws, size_t ws_size, hipStream_t stream) {
    static int grid_blocks = 0;
    if (!grid_blocks) {
        int dev = 0, cus = 0, per_cu = 0;
        hipGetDevice(&dev);
        hipDeviceGetAttribute(&cus, hipDeviceAttributeMultiprocessorCount, dev);
        hipFuncSetAttribute((const void*)fwd_megakernel, hipFuncAttributeMaxDynamicSharedMemorySize, LDS_BYTES);
        hipOccupancyMaxActiveBlocksPerMultiprocessor(&per_cu, (const void*)fwd_megakernel, 512, LDS_BYTES);
        if (per_cu < 1) per_cu = 1;
        grid_blocks = cus * per_cu;
        if (n_in != 21 || ws_size < WS_END) fprintf(stderr, "kernel_launch: unexpected n_in %d or ws_size %zu\n", n_in, ws_size);
    }
    Params p{};
    for (int i = 0; i < 21; ++i) p.in[i] = (const float*)d_in[i];
    p.out = (float*)d_out; p.ws = (unsigned char*)d_ws;
    void* args[] = {&p};
    hipError_t e = hipLaunchCooperativeKernel((const void*)fwd_megakernel, dim3(grid_blocks), dim3(512), args, LDS_BYTES, stream);
    if (e != hipSuccess) fprintf(stderr, "cooperative launch failed: %s (grid %d)\n", hipGetErrorString(e), grid_blocks);
}
```

```cpp
#include <hip/hip_runtime.h>
#include <hip/hip_cooperative_groups.h>
#include <cstdio>
#include <cstdint>
#define LAS __attribute__((address_space(3)))
namespace pg8 {
#define PG8_LAS __attribute__((address_space(3)))
typedef unsigned short bf16_t;
typedef short bf16x8 __attribute__((ext_vector_type(8)));
typedef float f32x4 __attribute__((ext_vector_type(4)));
typedef unsigned u32x4 __attribute__((ext_vector_type(4)));
constexpr int BM = 256, BK = 64, HALF = 128, HTB = HALF * BK * 2  , STAGE_BYTES = 8 * HTB, NXCD = 8, WGM = 8;

__host__ __device__ __forceinline__ int lds_byte(int r, int c) { const int st = (r >> 4) * 2 + (c >> 5), rr = r & 15, cc = c & 31, ob = rr * 64 + cc * 2; return st * 1024 + (ob ^ (((ob >> 9) & 1) << 5)); }
__host__ __device__ __forceinline__ void stage_rc(int b, int& R, int& C) { const int st = b / 1024, sb = b % 1024, swz = sb ^ (((sb >> 9) & 1) << 5); R = (st >> 1) * 16 + swz / 64; C = (st & 1) * 32 + (swz % 64) / 2; }
__host__ __device__ __forceinline__ int perm32(int rho) { const int n = rho >> 4, i = rho & 15; return 8 * (i >> 2) + 4 * n + (i & 3); }

struct Unit { int pm, pn; };
struct Gemm { const bf16_t* A; const bf16_t* Bt; int M, N, K; };

struct StaticOrder {
    int nM, nN, nwg, G, c;
    __host__ __device__ void init(int M, int N, int G_, int c_) { nM = M / BM; nN = N / BM; nwg = nM * nN; G = G_; c = c_; }
    __host__ __device__ bool next(int i, Unit& u) const {
        const long L = (long)i * G + c; if (L >= nwg) return false;
        int wgid = (int)L; { const int q = nwg / NXCD, r = nwg % NXCD, xcd = wgid % NXCD, off = wgid / NXCD; wgid = (xcd < r ? xcd * (q + 1) : r * (q + 1) + (xcd - r) * q) + off; }
        const int nig = WGM * nN, gid = wgid / nig, fm = gid * WGM, gsz = (nM - fm) < WGM ? (nM - fm) : WGM;
        u.pm = fm + ((wgid % nig) % gsz); u.pn = (wgid % nig) / gsz; return true;
    }
    __device__ __forceinline__ void a_ready(const Unit&) const {}
    __device__ __forceinline__ void done(const Unit&) const {}
};

__device__ __forceinline__ unsigned cvt_pk_bf16(float lo, float hi) { unsigned r; asm volatile("v_cvt_pk_bf16_f32 %0, %1, %2" : "=v"(r) : "v"(lo), "v"(hi)); return r; }
typedef float f32x2 __attribute__((ext_vector_type(2)));
template <class Epi, class Sched, bool ALIGN_EPI = false, bool SP2 = false>
__device__ __forceinline__ void gemm_phase(PG8_LAS unsigned char* lds, const Gemm g, const Sched& S, const Epi& E) {
    const int tid = threadIdx.x, wid = __builtin_amdgcn_readfirstlane(tid >> 6), lane = tid & 63, wr = wid >> 2, wc = wid & 3, fr = lane & 15, fq = lane >> 4;
    const int K = g.K, nt = K / BK;
    unsigned voffA[2], voffB[2];
#pragma unroll
    for (int i = 0; i < 2; ++i) { int R, C; stage_rc(tid * 16 + i * 8192, R, C); const int Rb = Epi::PERM ? ((R & ~31) + perm32(R & 31)) : R;
        voffA[i] = (unsigned)(R * K + C) * 2u; voffB[i] = (unsigned)(Rb * K + C) * 2u; }
    const size_t kstep = (size_t)(BK * 2);
    const size_t hstep = (size_t)HALF * K * 2;
    const size_t tstep = 2 * hstep;
    const unsigned ldsw = (unsigned)wid * 1024u;
    const int aoff = lds_byte(wr * 64 + fr, fq * 8), boff = lds_byte(wc * 32 + fr, fq * 8);
#define PG8_SA(b, h) (((b) * 2 + (h)) * HTB)
#define PG8_SB(b, h) ((4 + (b) * 2 + (h)) * HTB)
#define PG8_STAGE(bufoff, gbase, voff) do { _Pragma("unroll") for (int _i = 0; _i < 2; ++_i) \
        __builtin_amdgcn_global_load_lds((const unsigned*)((const char*)(gbase) + (voff)[_i]), (PG8_LAS unsigned*)(lds + (bufoff) + ldsw + _i * 8192), 16, 0, 0); } while (0)
#define PG8_LDA(dst, b, h) do { _Pragma("unroll") for (int m = 0; m < 4; ++m) _Pragma("unroll") for (int k = 0; k < 2; ++k) dst[m][k] = *(const PG8_LAS bf16x8*)(lds + PG8_SA(b, h) + aoff + m * 2048 + k * 1024); } while (0)
#define PG8_LDB(dst, b, h) do { _Pragma("unroll") for (int n = 0; n < 2; ++n) _Pragma("unroll") for (int k = 0; k < 2; ++k) dst[n][k] = *(const PG8_LAS bf16x8*)(lds + PG8_SB(b, h) + boff + n * 2048 + k * 1024); } while (0)
#define PG8_MMA(ai, bj, At, Bt) do { __builtin_amdgcn_s_setprio(1); _Pragma("unroll") for (int m = 0; m < 4; ++m) _Pragma("unroll") for (int n = 0; n < 2; ++n) _Pragma("unroll") for (int k = 0; k < 2; ++k) \
        acc[ai][bj][m][n] = __builtin_amdgcn_mfma_f32_16x16x32_bf16(Bt[n][k], At[m][k], acc[ai][bj][m][n], 0, 0, 0); __builtin_amdgcn_s_setprio(0); } while (0)
#define PG8_WAIT_V(n) asm volatile("s_waitcnt vmcnt(" #n ")" ::: "memory")
#define PG8_WAIT_L(n) asm volatile("s_waitcnt lgkmcnt(" #n ")" ::: "memory")
#define PG8_BAR __builtin_amdgcn_s_barrier()
#define PG8_SCHED __builtin_amdgcn_sched_barrier(0)
    Unit cur, nxt; int ui = 0;
    if (!S.next(0, cur)) return;
    f32x4 acc[2][2][4][2];
#pragma unroll
    for (int a = 0; a < 2; ++a)
#pragma unroll
        for (int b = 0; b < 2; ++b)
#pragma unroll
            for (int m = 0; m < 4; ++m)
#pragma unroll
                for (int n = 0; n < 2; ++n) acc[a][b][m][n] = (f32x4){0.f, 0.f, 0.f, 0.f};
    bf16x8 At[4][2], B0[2][2], B1[2][2];
    const char* cA = (const char*)g.A + (size_t)cur.pm * tstep; const char* cB = (const char*)g.Bt + (size_t)cur.pn * tstep;
    S.a_ready(cur);
    if constexpr (SP2) {
        PG8_STAGE(PG8_SB(0, 0), cB, voffB); PG8_STAGE(PG8_SB(0, 1), cB + hstep, voffB); PG8_STAGE(PG8_SA(0, 0), cA, voffA); PG8_STAGE(PG8_SA(0, 1), cA + hstep, voffA);
        if (wr == 1) PG8_BAR;
        PG8_WAIT_V(2); PG8_BAR;
        PG8_STAGE(PG8_SB(1, 0), cB + kstep, voffB); PG8_STAGE(PG8_SA(1, 0), cA + kstep, voffA); PG8_STAGE(PG8_SB(1, 1), cB + hstep + kstep, voffB);
        PG8_WAIT_V(6); PG8_BAR;
    } else {
        PG8_STAGE(PG8_SB(0, 0), cB, voffB); PG8_STAGE(PG8_SA(0, 0), cA, voffA); PG8_STAGE(PG8_SB(0, 1), cB + hstep, voffB); PG8_STAGE(PG8_SA(0, 1), cA + hstep, voffA);
        if (wr == 1) PG8_BAR;
        PG8_WAIT_V(4); PG8_BAR;
        PG8_STAGE(PG8_SB(1, 0), cB + kstep, voffB); PG8_STAGE(PG8_SA(1, 0), cA + kstep, voffA); PG8_STAGE(PG8_SB(1, 1), cB + hstep + kstep, voffB);
        PG8_WAIT_V(6); PG8_BAR;
    }
    for (;;) {
        const bool has_next = S.next(ui + 1, nxt);
        const char* nA = has_next ? (const char*)g.A + (size_t)nxt.pm * tstep : cA; const char* nB = has_next ? (const char*)g.Bt + (size_t)nxt.pn * tstep : cB;
        for (int t = 0; t < nt; t += 2) {
            const bool last = (t == nt - 2);
            const char* a1 = cA + (size_t)(t + 1) * kstep;
            const char* a2 = last ? nA : cA + (size_t)(t + 2) * kstep; const char* b2 = last ? nB : cB + (size_t)(t + 2) * kstep;
            const char* a3 = a2 + kstep; const char* b3 = b2 + kstep;
            if (last && has_next) S.a_ready(nxt);
            if constexpr (SP2) {
            PG8_LDB(B0, 0, 0); PG8_LDB(B1, 0, 1); PG8_SCHED; PG8_LDA(At, 0, 0); PG8_STAGE(PG8_SA(1, 1), a1 + hstep, voffA);
            PG8_WAIT_V(8); PG8_WAIT_L(0); PG8_BAR; PG8_MMA(0, 0, At, B0); PG8_MMA(0, 1, At, B1); PG8_BAR; PG8_SCHED;
            PG8_LDA(At, 0, 1); PG8_STAGE(PG8_SB(0, 0), b2, voffB); PG8_STAGE(PG8_SB(0, 1), b2 + hstep, voffB); PG8_STAGE(PG8_SA(0, 0), a2, voffA);
            PG8_WAIT_V(8); PG8_WAIT_L(0); PG8_BAR; PG8_MMA(1, 0, At, B0); PG8_MMA(1, 1, At, B1); PG8_BAR; PG8_SCHED;
            PG8_LDB(B0, 1, 0); PG8_LDB(B1, 1, 1); PG8_SCHED; PG8_LDA(At, 1, 0); PG8_STAGE(PG8_SA(0, 1), a2 + hstep, voffA);
            PG8_WAIT_V(8); PG8_WAIT_L(0); PG8_BAR; PG8_MMA(0, 0, At, B0); PG8_MMA(0, 1, At, B1); PG8_BAR; PG8_SCHED;
            PG8_LDA(At, 1, 1); PG8_STAGE(PG8_SB(1, 0), b3, voffB); PG8_STAGE(PG8_SB(1, 1), b3 + hstep, voffB); PG8_STAGE(PG8_SA(1, 0), a3, voffA);
            PG8_WAIT_V(8); PG8_WAIT_L(0); PG8_BAR; PG8_MMA(1, 0, At, B0); PG8_MMA(1, 1, At, B1); PG8_BAR; PG8_SCHED;
            } else {
            PG8_LDB(B0, 0, 0); PG8_SCHED; PG8_LDA(At, 0, 0); PG8_STAGE(PG8_SA(1, 1), a1 + hstep, voffA);
            PG8_WAIT_L(8); PG8_BAR; PG8_WAIT_L(0); PG8_MMA(0, 0, At, B0); PG8_BAR; PG8_SCHED;
            PG8_LDB(B1, 0, 1); PG8_STAGE(PG8_SB(0, 0), b2, voffB);
            PG8_BAR; PG8_WAIT_L(0); PG8_MMA(0, 1, At, B1); PG8_BAR;
            PG8_LDA(At, 0, 1); PG8_STAGE(PG8_SA(0, 0), a2, voffA);
            PG8_BAR; PG8_WAIT_L(0); PG8_MMA(1, 0, At, B0); PG8_BAR; PG8_SCHED;
            PG8_STAGE(PG8_SB(0, 1), b2 + hstep, voffB);
            PG8_WAIT_V(6); PG8_BAR; PG8_MMA(1, 1, At, B1); PG8_BAR;
            PG8_LDB(B0, 1, 0); PG8_SCHED; PG8_LDA(At, 1, 0); PG8_STAGE(PG8_SA(0, 1), a2 + hstep, voffA);
            PG8_WAIT_L(8); PG8_BAR; PG8_WAIT_L(0); PG8_MMA(0, 0, At, B0); PG8_BAR; PG8_SCHED;
            PG8_LDB(B1, 1, 1); PG8_STAGE(PG8_SB(1, 0), b3, voffB);
            PG8_BAR; PG8_WAIT_L(0); PG8_MMA(0, 1, At, B1); PG8_BAR;
            PG8_LDA(At, 1, 1); PG8_STAGE(PG8_SA(1, 0), a3, voffA);
            PG8_BAR; PG8_WAIT_L(0); PG8_MMA(1, 0, At, B0); PG8_BAR; PG8_SCHED;
            PG8_STAGE(PG8_SB(1, 1), b3 + hstep, voffB);
            PG8_WAIT_V(6); PG8_BAR; PG8_MMA(1, 1, At, B1); PG8_BAR;
            }
        }
        if constexpr (ALIGN_EPI) { if (wr == 0) PG8_BAR; }
        if constexpr (!Epi::AFTER_DRAIN) { E(acc, cur, wr, wc, fr, fq); S.done(cur); }
        if (!has_next) break;
#pragma unroll
        for (int a = 0; a < 2; ++a)
#pragma unroll
            for (int b = 0; b < 2; ++b)
#pragma unroll
                for (int m = 0; m < 4; ++m)
#pragma unroll
                    for (int n = 0; n < 2; ++n) acc[a][b][m][n] = (f32x4){0.f, 0.f, 0.f, 0.f};
        cur = nxt; cA = nA; cB = nB; ++ui;
        if constexpr (ALIGN_EPI) { if (wr == 1) PG8_BAR; }
    }
    PG8_WAIT_V(0);
    if constexpr (!ALIGN_EPI) { if (wr == 0) PG8_BAR; }
    PG8_BAR;
    if constexpr (Epi::AFTER_DRAIN) { E.fused(acc, cur, wr, wc, fr, fq, lds, wid, lane); S.done(cur); }
#undef PG8_SA
#undef PG8_SB
#undef PG8_STAGE
#undef PG8_LDA
#undef PG8_LDB
#undef PG8_MMA
#undef PG8_WAIT_V
#undef PG8_WAIT_L
#undef PG8_BAR
#undef PG8_SCHED
}
}

namespace pg8 {
__device__ __forceinline__ float fast_sigmoid(float z) { return __builtin_amdgcn_rcpf(1.0f + __builtin_amdgcn_exp2f(-1.44269504089f * z)); }
__device__ __forceinline__ float gelu_tanh(float x) { const float z = 1.5957691216f * (x + 0.044715f * x * x * x); return x * fast_sigmoid(z); }
__device__ __forceinline__ float silu_f(float x) { return x * fast_sigmoid(x); }
typedef unsigned u32x2 __attribute__((ext_vector_type(2)));

struct EpiIn {
    static constexpr bool PERM = false, AFTER_DRAIN = false;
    bf16_t* Q; const float* rope;
    static constexpr size_t OK_ = (size_t)16640 * 512, OV_ = OK_ + (size_t)16640 * 128, OF_ = OV_ + (size_t)16640 * 128, OU_ = OF_ + (size_t)16640 * 256;
    __device__ __forceinline__ void operator()(const f32x4 (&acc)[2][2][4][2], const Unit& u, int wr, int wc, int fr, int fq) const {
        const int pn = u.pn;
        const int rbase = u.pm * BM + wr * 64 + fr;
        if (pn <= 2) {
#pragma unroll
            for (int ai = 0; ai < 2; ++ai)
#pragma unroll
                for (int m = 0; m < 4; ++m) {
                    const int row = rbase + ai * HALF + m * 16;
                    const bool latent = row < 16384;
                    const int pos = latent ? ((wc & 1) ? (row & 63) : (row >> 6)) : 0;
                    const f32x4 cs = *(const f32x4*)(rope + pos * 16 + 4 * fq);
                    const f32x4 sn = *(const f32x4*)(rope + 4096 + pos * 16 + 4 * fq);
#pragma unroll
                    for (int bj = 0; bj < 2; ++bj) {
                        const f32x4 x1 = acc[ai][bj][m][0], x2 = acc[ai][bj][m][1];
                        f32x4 o1 = x1, o2 = x2;
                        const bool isv = (pn == 2 && bj == 1);
                        if (!isv && latent) { o1 = x1 * cs - x2 * sn; o2 = x1 * sn + x2 * cs; }
                        bf16_t* dst;
                        if (pn < 2) { o1 = o1 * 0.18033688011f; o2 = o2 * 0.18033688011f; dst = Q + (size_t)row * 512 + pn * 256 + bj * HALF + wc * 32 + 4 * fq; }
                        else dst = Q + (bj == 0 ? OK_ : OV_) + (size_t)row * 128 + wc * 32 + 4 * fq;
                        u32x2 w0, w1; w0.x = cvt_pk_bf16(o1[0], o1[1]); w0.y = cvt_pk_bf16(o1[2], o1[3]); w1.x = cvt_pk_bf16(o2[0], o2[1]); w1.y = cvt_pk_bf16(o2[2], o2[3]);
                        *(u32x2*)dst = w0; *(u32x2*)(dst + 16) = w1;
                    }
                }
        } else {
            bf16_t* dstb = Q + OF_ + (size_t)(pn - 3) * ((size_t)16640 * 256);
            const bool act = pn >= 4;
#pragma unroll
            for (int ai = 0; ai < 2; ++ai)
#pragma unroll
                for (int m = 0; m < 4; ++m) {
                    const int row = rbase + ai * HALF + m * 16;
#pragma unroll
                    for (int bj = 0; bj < 2; ++bj)
#pragma unroll
                        for (int n = 0; n < 2; ++n) {
                            f32x4 v = acc[ai][bj][m][n];
                            if (act) { v[0] = gelu_tanh(v[0]); v[1] = gelu_tanh(v[1]); v[2] = gelu_tanh(v[2]); v[3] = gelu_tanh(v[3]); }
                            u32x2 w; w.x = cvt_pk_bf16(v[0], v[1]); w.y = cvt_pk_bf16(v[2], v[3]);
                            *(u32x2*)(dstb + (size_t)row * 256 + bj * HALF + wc * 32 + 16 * n + 4 * fq) = w;
                        }
                }
        }
    }
};

struct EpiSwiglu {
    static constexpr bool PERM = true, AFTER_DRAIN = false;
    bf16_t* O; int ldc;
    __device__ __forceinline__ void operator()(const f32x4 (&acc)[2][2][4][2], const Unit& u, int wr, int wc, int fr, int fq) const {
        const int row0 = u.pm * BM + wr * 64 + fr, col0 = u.pn * HALF + wc * 32 + 8 * fq;
#pragma unroll
        for (int ai = 0; ai < 2; ++ai)
#pragma unroll
            for (int m = 0; m < 4; ++m) {
                bf16_t* rowp = O + (size_t)(row0 + ai * HALF + m * 16) * ldc + col0;
                f32x4 h0, h1;
#pragma unroll
                for (int j = 0; j < 4; ++j) { h0[j] = silu_f(acc[ai][0][m][0][j]) * acc[ai][1][m][0][j]; h1[j] = silu_f(acc[ai][0][m][1][j]) * acc[ai][1][m][1][j]; }
                u32x4 w; w.x = cvt_pk_bf16(h0[0], h0[1]); w.y = cvt_pk_bf16(h0[2], h0[3]); w.z = cvt_pk_bf16(h1[0], h1[1]); w.w = cvt_pk_bf16(h1[2], h1[3]);
                *(u32x4*)rowp = w;
            }
    }
};

struct EpiRes {
    static constexpr bool PERM = false, AFTER_DRAIN = false;
    const float* res; float* out; const float* gate; const float* res_c; float* out_c; const float* gate_c; float alpha;
    __device__ __forceinline__ void operator()(const f32x4 (&acc)[2][2][4][2], const Unit& u, int wr, int wc, int fr, int fq) const {
        const bool isc = (u.pm == 64);
        const float* rp = isc ? res_c : res; float* op = isc ? out_c : out; const float* gp = isc ? gate_c : gate;
        const int row0 = (isc ? 0 : u.pm * BM) + wr * 64 + fr, col0 = u.pn * BM + wc * 32 + 4 * fq;
        f32x4 gv[2][2];
#pragma unroll
        for (int bj = 0; bj < 2; ++bj)
#pragma unroll
            for (int n = 0; n < 2; ++n) gv[bj][n] = *(const f32x4*)(gp + col0 + bj * HALF + n * 16);
#pragma unroll
        for (int ai = 0; ai < 2; ++ai)
#pragma unroll
            for (int m = 0; m < 4; ++m) {
                const size_t off = (size_t)(row0 + ai * HALF + m * 16) * 1024 + col0;
#pragma unroll
                for (int bj = 0; bj < 2; ++bj)
#pragma unroll
                    for (int n = 0; n < 2; ++n) {
                        const f32x4 r = *(const f32x4*)(rp + off + bj * HALF + n * 16);
                        *(f32x4*)(op + off + bj * HALF + n * 16) = r * alpha + gv[bj][n] * acc[ai][bj][m][n];
                    }
            }
    }
};

struct OrderX {
    StaticOrder so; int extra, xpn;
    __device__ void init(int M, int N, int G, int c, int extra_, int xpn_) { so.init(M, N, G, c); extra = extra_; xpn = xpn_; }
    __device__ bool next(int i, Unit& u) const {
        if (so.next(i, u)) return true;
        const long L = (long)i * so.G + so.c;
        if (extra && L == so.nwg) { u.pm = 64; u.pn = xpn; return true; }
        return false;
    }
    __device__ __forceinline__ void a_ready(const Unit&) const {}
    __device__ __forceinline__ void done(const Unit&) const {}
};
}

namespace cg = cooperative_groups;
typedef unsigned short bf16;
typedef short bf16x8 __attribute__((ext_vector_type(8)));
typedef short s16x4 __attribute__((ext_vector_type(4)));
typedef float f32x4 __attribute__((ext_vector_type(4)));
typedef unsigned u32x4 __attribute__((ext_vector_type(4)));
typedef unsigned u32x2 __attribute__((ext_vector_type(2)));
#define MFMA16(a, b, c) __builtin_amdgcn_mfma_f32_16x16x32_bf16((a), (b), (c), 0, 0, 0)

constexpr int NTOK = 16384, NCTX = 256, MROWS = NTOK + NCTX, DM = 1024, DFF = 2816, DIN = 1536;
constexpr float ALPHA_DN = 1.41421356237f, LN_EPS = 1e-6f, LOG2E = 1.44269504089f;
constexpr size_t MiB = 1u << 20;
constexpr size_t WS_W1 = 1 * MiB;
constexpr size_t WS_W2 = WS_W1 + 65536;
constexpr size_t WS_WC = WS_W2 + 131072;
constexpr size_t WS_ROPE = WS_WC + 262144;
constexpr size_t WS_TW = WS_ROPE + 32768;
constexpr size_t WS_WS = WS_TW + 131072;
constexpr size_t WS_WFC = WS_WS + 262144;
constexpr size_t WS_MOD = 3 * MiB;
constexpr size_t WS_WIN = 4 * MiB, WS_WOUT = 10 * MiB, WS_WF1 = 14 * MiB, WS_WF2 = 36 * MiB, WS_XC = 47 * MiB, WS_H = 48 * MiB, WS_ACT = 81 * MiB;
constexpr size_t WS_Q = WS_ACT, WS_K = WS_Q + (size_t)MROWS * 512 * 2, WS_V = WS_K + (size_t)MROWS * 128 * 2, WS_F = WS_V + (size_t)MROWS * 128 * 2,
                 WS_U = WS_F + (size_t)MROWS * 256 * 2, WS_G = WS_U + (size_t)MROWS * 256 * 2, WS_O = WS_G + (size_t)MROWS * 256 * 2,
                 WS_Y = WS_O + (size_t)MROWS * 1024 * 2, WS_YEND = WS_Y + (size_t)128 * 128 * 2 * 256 * 2;
constexpr size_t WS_HMID = WS_ACT, WS_END = 200 * MiB;
static_assert(WS_WFC + 262144 <= WS_MOD && WS_YEND <= WS_END && WS_HMID + (size_t)MROWS * DFF * 2 <= WS_END && WS_H + (size_t)MROWS * DM * 2 <= WS_ACT, "ws map");
constexpr int LDS_BYTES = 147456;

__device__ __forceinline__ unsigned f2bf(float f) { unsigned u = __builtin_bit_cast(unsigned, f); return (u + 0x7fffu + ((u >> 16) & 1u)) >> 16; }
__device__ __forceinline__ unsigned pk2(float lo, float hi) { return f2bf(lo) | (f2bf(hi) << 16); }
__device__ __forceinline__ float bf2f(unsigned short b) { return __builtin_bit_cast(float, (unsigned)b << 16); }
__device__ __forceinline__ float wave_sum(float v) {
#pragma unroll
    for (int o = 1; o < 64; o <<= 1) v += __shfl_xor(v, o);
    return v;
}

typedef short v4i16_t __attribute__((ext_vector_type(4)));
__device__ __forceinline__ s16x4 tr16(const LAS bf16* p) { return __builtin_bit_cast(s16x4, __builtin_amdgcn_ds_read_tr16_b64_v4i16((LAS v4i16_t*)p)); }
__device__ __forceinline__ bf16x8 tr16x2(const LAS bf16* p, int hi_off) { const s16x4 lo = tr16(p), hi = tr16(p + hi_off); return __builtin_shufflevector(lo, hi, 0, 1, 2, 3, 4, 5, 6, 7); }
struct Params { const float* in[21]; float* out; unsigned char* ws; };
typedef const __attribute__((address_space(4))) Params* KP;
__device__ __forceinline__ KP kparams() { KP k = (KP)__builtin_amdgcn_kernarg_segment_ptr(); asm volatile("" : "+s"(k)); return k; }
enum { I_X = 0, I_C, I_CTX, I_CCTX, I_WADA, I_BADA, I_WIN, I_WOUT, I_SINK, I_WFOUR, I_BFOUR, I_SLNG, I_SLNB, I_WSP, I_BSP, I_LN1G, I_LN1B, I_WF1, I_WF2, I_LN2G, I_LN2B };

__device__ __forceinline__ void transpose_item(const float* W, int K, int N, bf16* WT, int mode, LAS float* scr, int item, int lane) {
    const int nblk = N / 32, kb = item / nblk, nb = item % nblk, k0 = 64 * kb, n0 = 32 * nb;
    int r0 = n0;
    if (mode == 1) { r0 = (n0 < DFF) ? (256 * (n0 / 128) + (n0 % 128)) : (256 * ((n0 - DFF) / 128) + 128 + ((n0 - DFF) % 128)); }
#pragma unroll 8
    for (int i = 0; i < 32; ++i) { const int kk = 2 * i + (lane >> 5); scr[kk * 33 + (lane & 31)] = W[(size_t)(k0 + kk) * N + n0 + (lane & 31)]; }
    asm volatile("s_waitcnt lgkmcnt(0)" ::: "memory");
    const int c = lane & 7;
#pragma unroll
    for (int j = 0; j < 4; ++j) { const int n = (lane >> 3) + 8 * j; const LAS float* s = scr + (8 * c) * 33 + n;
        u32x4 o; o.x = pk2(s[0 * 33], s[1 * 33]); o.y = pk2(s[2 * 33], s[3 * 33]); o.z = pk2(s[4 * 33], s[5 * 33]); o.w = pk2(s[6 * 33], s[7 * 33]);
        *(u32x4*)(WT + (size_t)(r0 + n) * K + k0 + 8 * c) = o; }
    asm volatile("s_waitcnt lgkmcnt(0)" ::: "memory");
}

__device__ __forceinline__ void ada_item(LAS unsigned char* lds, KP p, int item) {
    LAS float* sc = (LAS float*)lds;
    LAS float* red = sc + 2048;
    const int tid = threadIdx.x, lane = tid & 63, w = tid >> 6;
    const int l = item / 96, j = item % 96;
    __syncthreads();
    for (int i = tid; i < 2048; i += 512) { const float v = (i < 1024) ? p->in[I_C][i] : p->in[I_CCTX][i - 1024]; sc[i] = v / (1.0f + __expf(-v)); }
    __syncthreads();
    const float* W = p->in[I_WADA] + (size_t)l * 1024 * 6144 + 64 * j + lane;
    float a0 = 0.f, a1 = 0.f;
#pragma unroll 8
    for (int k = 128 * w; k < 128 * w + 128; ++k) { const float wv = W[(size_t)k * 6144]; a0 += sc[k] * wv; a1 += sc[1024 + k] * wv; }
    red[(w * 2 + 0) * 64 + lane] = a0; red[(w * 2 + 1) * 64 + lane] = a1;
    __syncthreads();
    if (tid < 128) {
        const int v = tid >> 6; float s = 0.f;
#pragma unroll
        for (int ww = 0; ww < 8; ++ww) s += red[(ww * 2 + v) * 64 + lane];
        s += p->in[I_BADA][l * 6144 + 64 * j + lane];
        ((float*)(p->ws + WS_MOD))[(l * 2 + v) * 6144 + 64 * j + lane] = s;
    }
}

__device__ __forceinline__ void tables(KP p, int gtid, int gthreads) {
    bf16* W1 = (bf16*)(p->ws + WS_W1); bf16* W2 = (bf16*)(p->ws + WS_W2); bf16* WC = (bf16*)(p->ws + WS_WC);
    float* ROPE = (float*)(p->ws + WS_ROPE); float* TW = (float*)(p->ws + WS_TW); bf16* WSb = (bf16*)(p->ws + WS_WS); bf16* WFC = (bf16*)(p->ws + WS_WFC);
    for (int i = gtid; i < 256 * 128; i += gthreads) { const int row = i >> 7, n1 = i & 127, part = row >> 7, k1 = row & 127; const float s = sinpif((float)((k1 * n1) & 127) * (1.0f / 64.0f)), c = cospif((float)((k1 * n1) & 127) * (1.0f / 64.0f)); W1[i] = (bf16)f2bf(part ? -s : c); }
    for (int i = gtid; i < 256 * 256; i += gthreads) { const int row = i >> 8, kap = i & 255, pp = row >> 7, k2 = row & 127, part = kap >> 7, n2 = kap & 127; const float s = sinpif((float)((k2 * n2) & 127) * (1.0f / 64.0f)), c = cospif((float)((k2 * n2) & 127) * (1.0f / 64.0f));
        const float v = (pp == 0) ? (part == 0 ? c : s) : (part == 0 ? -s : c); W2[i] = (bf16)f2bf(v); }
    for (int i = gtid; i < 512 * 256; i += gthreads) { const int row = i >> 8, n = i & 255, part = row >> 8, k = row & 255; const float s = sinpif((float)((k * n) & 255) * (1.0f / 128.0f)), c = cospif((float)((k * n) & 255) * (1.0f / 128.0f)); WC[i] = (bf16)f2bf(part ? -s : c); }
    for (int i = gtid; i < 256 * 16; i += gthreads) { const int pos = i >> 4, fi = i & 15; const float fr = powf(10000.0f, -(float)(2 * fi) / 32.0f); const float ang = (float)pos * fr; ROPE[i] = cosf(ang); ROPE[4096 + i] = sinf(ang); }
    for (int i = gtid; i < 16384; i += gthreads) { const float s = sinpif((float)i * (1.0f / 8192.0f)), c = cospif((float)i * (1.0f / 8192.0f)); TW[2 * i] = c; TW[2 * i + 1] = s; }
    for (int i = gtid; i < 2 * 4 * 128 * 128; i += gthreads) WSb[i] = (bf16)f2bf(p->in[I_WSP][i]);
    for (int i = gtid; i < 2 * 2 * 4 * 64 * 128; i += gthreads) {
        const int K = i & 127, d = (i >> 7) & 63, g = (i >> 13) & 3, v = (i >> 15) & 1, l = i >> 16, part = K >> 6, cc = K & 63;
        const float* wf = p->in[I_WFOUR] + ((size_t)(l * 4 + g) * 64) * 64 + d; float acc = 0.f;
        for (int m = 0; m < 64; ++m) { const float s = sinpif((float)((m * cc) & 63) * (1.0f / 32.0f)), c = cospif((float)((m * cc) & 63) * (1.0f / 32.0f)); acc += (part ? s : c) * wf[m * 64]; }
        WFC[i] = (bf16)f2bf(acc * (v ? (1.0f / 128.0f) : (1.0f / 1024.0f)));
    }
}

__device__ __forceinline__ void ln_row(const float* in, float* out, const float* ga, const float* be, bf16* hrow, const float* sh, const float* sc, int lane) {
    f32x4 v[4];
#pragma unroll
    for (int j = 0; j < 4; ++j) v[j] = ((const f32x4*)in)[lane + 64 * j];
    if (ga) {
        float s = 0.f;
#pragma unroll
        for (int j = 0; j < 4; ++j) s += (v[j][0] + v[j][1]) + (v[j][2] + v[j][3]);
        const float mean = wave_sum(s) * (1.0f / DM); float q = 0.f;
#pragma unroll
        for (int j = 0; j < 4; ++j) { v[j] = v[j] - mean; q += (v[j][0] * v[j][0] + v[j][1] * v[j][1]) + (v[j][2] * v[j][2] + v[j][3] * v[j][3]); }
        const float rstd = 1.0f / sqrtf(wave_sum(q) * (1.0f / DM) + LN_EPS);
#pragma unroll
        for (int j = 0; j < 4; ++j) { const f32x4 g4 = ((const f32x4*)ga)[lane + 64 * j], b4 = ((const f32x4*)be)[lane + 64 * j]; v[j] = v[j] * rstd * g4 + b4; ((f32x4*)out)[lane + 64 * j] = v[j]; }
    }
    if (hrow) {
        float s = 0.f;
#pragma unroll
        for (int j = 0; j < 4; ++j) s += (v[j][0] + v[j][1]) + (v[j][2] + v[j][3]);
        const float mean = wave_sum(s) * (1.0f / DM); float q = 0.f;
#pragma unroll
        for (int j = 0; j < 4; ++j) { v[j] = v[j] - mean; q += (v[j][0] * v[j][0] + v[j][1] * v[j][1]) + (v[j][2] * v[j][2] + v[j][3] * v[j][3]); }
        const float rstd = 1.0f / sqrtf(wave_sum(q) * (1.0f / DM) + LN_EPS);
#pragma unroll
        for (int j = 0; j < 4; ++j) { const f32x4 s4 = ((const f32x4*)sh)[lane + 64 * j], c4 = ((const f32x4*)sc)[lane + 64 * j]; const f32x4 h = v[j] * rstd * (c4 + 1.0f) + s4;
            u32x2 w; w.x = pk2(h[0], h[1]); w.y = pk2(h[2], h[3]); ((u32x2*)hrow)[lane + 64 * j] = w; }
    }
}

__device__ __forceinline__ void attn_unit(LAS unsigned char* lds, const bf16* Q, const bf16* K, const bf16* V, bf16* O, const float* sink, int qrow0, int qpos0, int kvh, int wlo, int whi) {
    int tid = threadIdx.x; asm volatile("" : "+v"(tid));
    const int lane = tid & 63, w = tid >> 6, r16 = lane & 15, g = lane >> 4;
    LAS bf16* KS = (LAS bf16*)lds;
    LAS bf16* VS = (LAS bf16*)(lds + 64 * 72 * 2);
    const int hq = 4 * kvh + (w >> 1), qw = 64 * (w & 1);
    LAS bf16* QS = (LAS bf16*)(lds + 18432 + w * 9216);
    __syncthreads();
#pragma unroll 2
    for (int i = 0; i < 8; ++i) { const int idx = lane + 64 * i, qr = idx >> 3, ch = idx & 7;
        *(LAS u32x4*)(QS + qr * 72 + ch * 8) = *(const u32x4*)(Q + (size_t)(qrow0 + qw + qr) * 512 + hq * 64 + ch * 8); }
    f32x4 oacc[4][4];
#pragma unroll
    for (int a = 0; a < 4; ++a)
#pragma unroll
        for (int b = 0; b < 4; ++b) oacc[a][b] = (f32x4){0.f, 0.f, 0.f, 0.f};
    float mrun[4], lrun[4];
    const float sk = sink[hq] * LOG2E;
#pragma unroll
    for (int qt = 0; qt < 4; ++qt) { mrun[qt] = sk; lrun[qt] = (g == 0) ? 1.0f : 0.0f; }
    const int nwin = whi - wlo, ntiles = nwin + 4;
    const int lk = tid >> 3, lc = tid & 7;
    u32x4 kreg, vreg;
    { const int row = (0 < nwin ? wlo * 64 : NTOK) + lk; kreg = *(const u32x4*)(K + (size_t)row * 128 + kvh * 64 + lc * 8); vreg = *(const u32x4*)(V + (size_t)row * 128 + kvh * 64 + lc * 8); }
    for (int t = 0; t < ntiles; ++t) {
        __syncthreads();
        *(LAS u32x4*)(KS + lk * 72 + lc * 8) = kreg;
        *(LAS u32x4*)(VS + lk * 72 + lc * 8) = vreg;
        __syncthreads();
        if (t + 1 < ntiles) { const int tn = t + 1; const int row = (tn < nwin ? (wlo + tn) * 64 : NTOK + (tn - nwin) * 64) + lk;
            kreg = *(const u32x4*)(K + (size_t)row * 128 + kvh * 64 + lc * 8); vreg = *(const u32x4*)(V + (size_t)row * 128 + kvh * 64 + lc * 8); }
        const bool win = t < nwin; const int kpos0 = (wlo + t) * 64;
#pragma unroll
        for (int qh = 0; qh < 2; ++qh) {
            f32x4 s[4][2];
#pragma unroll
            for (int a = 0; a < 4; ++a)
#pragma unroll
                for (int b = 0; b < 2; ++b) s[a][b] = (f32x4){0.f, 0.f, 0.f, 0.f};
#pragma unroll
            for (int ks = 0; ks < 2; ++ks) {
                bf16x8 kf[4];
#pragma unroll
                for (int kt = 0; kt < 4; ++kt) kf[kt] = *(const LAS bf16x8*)(KS + (16 * kt + r16) * 72 + 32 * ks + 8 * g);
                bf16x8 qfr[2];
#pragma unroll
                for (int q2 = 0; q2 < 2; ++q2) qfr[q2] = *(const LAS bf16x8*)(QS + (16 * (2 * qh + q2) + r16) * 72 + 32 * ks + 8 * g);
#pragma unroll
                for (int kt = 0; kt < 4; ++kt)
#pragma unroll
                    for (int q2 = 0; q2 < 2; ++q2) s[kt][q2] = MFMA16(kf[kt], qfr[q2], s[kt][q2]);
            }
            if (win) {
#pragma unroll
                for (int kt = 0; kt < 4; ++kt)
#pragma unroll
                    for (int q2 = 0; q2 < 2; ++q2)
#pragma unroll
                        for (int j = 0; j < 4; ++j) { const int d = (kpos0 + 16 * kt + 4 * g + j) - (qpos0 + qw + 16 * (2 * qh + q2) + r16); if (d > 128 || d < -128) s[kt][q2][j] = -INFINITY; }
            }
#pragma unroll
            for (int q2 = 0; q2 < 2; ++q2) {
                const int qt = 2 * qh + q2;
                float mx = -INFINITY;
#pragma unroll
                for (int kt = 0; kt < 4; ++kt)
#pragma unroll
                    for (int j = 0; j < 4; ++j) mx = fmaxf(mx, s[kt][q2][j]);
                mx = fmaxf(mx, __shfl_xor(mx, 16)); mx = fmaxf(mx, __shfl_xor(mx, 32));
                const float mnew = fmaxf(mrun[qt], mx); const float alpha = __builtin_amdgcn_exp2f(mrun[qt] - mnew); mrun[qt] = mnew;
                float ps = 0.f;
#pragma unroll
                for (int kt = 0; kt < 4; ++kt)
#pragma unroll
                    for (int j = 0; j < 4; ++j) { const float pv = __builtin_amdgcn_exp2f(s[kt][q2][j] - mnew); s[kt][q2][j] = pv; ps += pv; }
                lrun[qt] = lrun[qt] * alpha + ps;
#pragma unroll
                for (int dt = 0; dt < 4; ++dt) oacc[dt][qt] = oacc[dt][qt] * alpha;
            }
#pragma unroll
            for (int kp = 0; kp < 2; ++kp) {
                bf16x8 pf[2];
#pragma unroll
                for (int q2 = 0; q2 < 2; ++q2) { u32x4 pw; pw.x = pk2(s[2 * kp][q2][0], s[2 * kp][q2][1]); pw.y = pk2(s[2 * kp][q2][2], s[2 * kp][q2][3]);
                    pw.z = pk2(s[2 * kp + 1][q2][0], s[2 * kp + 1][q2][1]); pw.w = pk2(s[2 * kp + 1][q2][2], s[2 * kp + 1][q2][3]); pf[q2] = __builtin_bit_cast(bf16x8, pw); }
#pragma unroll
                for (int dt = 0; dt < 4; ++dt) {
                    const bf16x8 vf = tr16x2(VS + (32 * kp + 4 * g + (r16 >> 2)) * 72 + 16 * dt + 4 * (r16 & 3), 16 * 72);
#pragma unroll
                    for (int q2 = 0; q2 < 2; ++q2) oacc[dt][2 * qh + q2] = MFMA16(vf, pf[q2], oacc[dt][2 * qh + q2]);
                }
            }
            __builtin_amdgcn_sched_barrier(0);
        }
    }
#pragma unroll
    for (int qt = 0; qt < 4; ++qt) {
        float l = lrun[qt]; l += __shfl_xor(l, 16); l += __shfl_xor(l, 32);
        const float inv = 1.0f / l;
        bf16* orow = O + (size_t)(qrow0 + qw + 16 * qt + r16) * 1024 + hq * 64 + 4 * g;
#pragma unroll
        for (int dt = 0; dt < 4; ++dt) { const f32x4 o = oacc[dt][qt] * inv; u32x2 wv; wv.x = pk2(o[0], o[1]); wv.y = pk2(o[2], o[3]); *(u32x2*)(orow + 16 * dt) = wv; }
    }
}

__device__ __forceinline__ void attn_unit_ref(const bf16* Q, const bf16* K, const bf16* V, bf16* O, const float* sink, int qrow0, int qpos0, int hq, int wlo, int whi) {
    int tid = threadIdx.x; asm volatile("" : "+v"(tid));
    const int qi = tid >> 2, part = tid & 3, kvh = hq >> 2;
    float q[16], o[16];
    { const bf16* qp = Q + (size_t)(qrow0 + qi) * 512 + hq * 64 + part * 16;
#pragma unroll
      for (int e = 0; e < 16; ++e) { q[e] = bf2f(qp[e]); o[e] = 0.f; } }
    float m = sink[hq] * LOG2E, l = 1.0f;
    const int nwin = (whi - wlo) * 64, nk = nwin + 256;
#pragma unroll 1
    for (int j = 0; j < nk; ++j) {
        const int row = j < nwin ? wlo * 64 + j : NTOK + (j - nwin);
        const bf16* kp = K + (size_t)row * 128 + kvh * 64 + part * 16; const bf16* vp = V + (size_t)row * 128 + kvh * 64 + part * 16;
        float s = 0.f;
#pragma unroll
        for (int e = 0; e < 16; ++e) s += q[e] * bf2f(kp[e]);
        s += __shfl_xor(s, 1); s += __shfl_xor(s, 2);
        if (j < nwin) { const int d = row - (qpos0 + qi); if (d > 128 || d < -128) s = -INFINITY; }
        const float mn = fmaxf(m, s), a = exp2f(m - mn), pj = exp2f(s - mn); m = mn; l = l * a + pj;
#pragma unroll
        for (int e = 0; e < 16; ++e) o[e] = o[e] * a + pj * bf2f(vp[e]);
    }
    const float inv = 1.0f / l;
    bf16* op = O + (size_t)(qrow0 + qi) * 1024 + hq * 64 + part * 16;
#pragma unroll
    for (int e = 0; e < 16; ++e) op[e] = (bf16)f2bf(o[e] * inv);
}

__device__ __forceinline__ void sgu_unit(LAS unsigned char* lds, const bf16* U, const bf16* G, bf16* O, const bf16* WSb, const float* bs, const float* lng, const float* lnb, int row0) {
    int tid = threadIdx.x; asm volatile("" : "+v"(tid));
    const int lane = tid & 63, w = tid >> 6, r16 = lane & 15, g = lane >> 4;
    LAS bf16* VN = (LAS bf16*)lds;
    __syncthreads();
    { const int q = tid >> 2, part = tid & 3;
#pragma unroll 1
      for (int h = 0; h < 4; ++h) {
        const u32x4 a = *(const u32x4*)(G + (size_t)(row0 + q) * 256 + h * 64 + part * 16), b = *(const u32x4*)(G + (size_t)(row0 + q) * 256 + h * 64 + part * 16 + 8);
        float x[16];
#pragma unroll
        for (int e = 0; e < 4; ++e) { x[2 * e] = bf2f((unsigned short)(a[e] & 0xffffu)); x[2 * e + 1] = bf2f((unsigned short)(a[e] >> 16)); x[8 + 2 * e] = bf2f((unsigned short)(b[e] & 0xffffu)); x[8 + 2 * e + 1] = bf2f((unsigned short)(b[e] >> 16)); }
        float s = 0.f;
#pragma unroll
        for (int e = 0; e < 16; ++e) s += x[e];
        s += __shfl_xor(s, 1); s += __shfl_xor(s, 2);
        const float mean = s * (1.0f / 64.0f); float qq = 0.f;
#pragma unroll
        for (int e = 0; e < 16; ++e) { x[e] -= mean; qq += x[e] * x[e]; }
        qq += __shfl_xor(qq, 1); qq += __shfl_xor(qq, 2);
        const float rstd = 1.0f / sqrtf(qq * (1.0f / 64.0f) + LN_EPS);
#pragma unroll
        for (int e = 0; e < 16; ++e) { const int dd = part * 16 + e; x[e] = x[e] * rstd * lng[h * 64 + dd] + lnb[h * 64 + dd]; }
        { u32x4 w0, w1; w0.x = pk2(x[0], x[1]); w0.y = pk2(x[2], x[3]); w0.z = pk2(x[4], x[5]); w0.w = pk2(x[6], x[7]); w1.x = pk2(x[8], x[9]); w1.y = pk2(x[10], x[11]); w1.z = pk2(x[12], x[13]); w1.w = pk2(x[14], x[15]);
          *(LAS u32x4*)(VN + q * 264 + h * 64 + part * 16) = w0; *(LAS u32x4*)(VN + q * 264 + h * 64 + part * 16 + 8) = w1; }
      } }
    __syncthreads();
#pragma unroll 1
    for (int h = 0; h < 4; ++h) {
        f32x4 acc[4];
#pragma unroll
        for (int nt = 0; nt < 4; ++nt) acc[nt] = (f32x4){0.f, 0.f, 0.f, 0.f};
#pragma unroll
        for (int ks = 0; ks < 4; ++ks) {
            const bf16x8 af = *(const bf16x8*)(WSb + ((size_t)h * 128 + 16 * w + r16) * 128 + 32 * ks + 8 * g);
#pragma unroll
            for (int nt = 0; nt < 4; ++nt) { const bf16x8 bfr = tr16x2(VN + (32 * ks + 8 * g + (r16 >> 2)) * 264 + h * 64 + 16 * nt + 4 * (r16 & 3), 4 * 264); acc[nt] = MFMA16(af, bfr, acc[nt]); }
        }
#pragma unroll
        for (int j = 0; j < 4; ++j) { const int pp = 16 * w + 4 * g + j; const float bias = bs[h * 128 + pp];
#pragma unroll
            for (int nt = 0; nt < 4; ++nt) { const int col = h * 64 + 16 * nt + r16; const float u = bf2f(U[(size_t)(row0 + pp) * 256 + col]); O[(size_t)(row0 + pp) * 1024 + 768 + col] = (bf16)f2bf(u * (acc[nt][j] + bias)); } }
    }
}

__device__ __forceinline__ void fft1_item(LAS unsigned char* lds, const bf16* F, bf16* Y, const bf16* W1, const float* TW, int n2, int hc) {
    int tid = threadIdx.x; asm volatile("" : "+v"(tid));
    const int lane = tid & 63, w = tid >> 6, r16 = lane & 15, g = lane >> 4;
    LAS bf16* FN = (LAS bf16*)lds;
    __syncthreads();
#pragma unroll 1
    for (int i = 0; i < 4; ++i) { const int idx = tid + 512 * i, n1 = idx >> 4, ch = idx & 15; *(LAS u32x4*)(FN + n1 * 136 + ch * 8) = *(const u32x4*)(F + (size_t)(128 * n1 + n2) * 256 + hc * 128 + ch * 8); }
    __syncthreads();
    f32x4 ar[8], ai[8];
#pragma unroll
    for (int nt = 0; nt < 8; ++nt) { ar[nt] = (f32x4){0.f, 0.f, 0.f, 0.f}; ai[nt] = (f32x4){0.f, 0.f, 0.f, 0.f}; }
#pragma unroll
    for (int ks = 0; ks < 4; ++ks) {
        const bf16x8 a_re = *(const bf16x8*)(W1 + (size_t)(16 * w + r16) * 128 + 32 * ks + 8 * g), a_im = *(const bf16x8*)(W1 + (size_t)(128 + 16 * w + r16) * 128 + 32 * ks + 8 * g);
#pragma unroll
        for (int nt = 0; nt < 8; ++nt) { const bf16x8 bfr = tr16x2(FN + (32 * ks + 8 * g + (r16 >> 2)) * 136 + 16 * nt + 4 * (r16 & 3), 4 * 136); ar[nt] = MFMA16(a_re, bfr, ar[nt]); ai[nt] = MFMA16(a_im, bfr, ai[nt]); }
    }
#pragma unroll
    for (int j = 0; j < 4; ++j) { const int k1 = 16 * w + 4 * g + j; const int m = (n2 * k1) & 16383; const float tc = TW[2 * m], ts = TW[2 * m + 1];
        bf16* yrow = Y + ((size_t)(n2 * 128 + k1) * 2) * 256 + hc * 128 + r16;
#pragma unroll
        for (int nt = 0; nt < 8; ++nt) { const float yr = ar[nt][j] * tc + ai[nt][j] * ts, yi = ai[nt][j] * tc - ar[nt][j] * ts; yrow[16 * nt] = (bf16)f2bf(yr); yrow[256 + 16 * nt] = (bf16)f2bf(yi); } }
}

__device__ __forceinline__ void fft2_item(LAS unsigned char* lds, const bf16* Bsrc, int sA, int sB, const bf16* Amat, int re_row0, int im_row0, const bf16* Wfc, const float* bfour, bf16* O, int tok0, int tok_stride, int hc) {
    int tid = threadIdx.x; asm volatile("" : "+v"(tid));
    const int lane = tid & 63, w = tid >> 6, r16 = lane & 15, g = lane >> 4;
    LAS bf16* YN = (LAS bf16*)lds;
    __syncthreads();
#pragma unroll 2
    for (int i = 0; i < 8; ++i) { const int idx = tid + 512 * i, kap = idx >> 4, ch = idx & 15; *(LAS u32x4*)(YN + kap * 136 + ch * 8) = *(const u32x4*)(Bsrc + (size_t)(kap >> 7) * sA + (size_t)(kap & 127) * sB + hc * 128 + ch * 8); }
    __syncthreads();
    f32x4 xr[8], xi[8];
#pragma unroll
    for (int nt = 0; nt < 8; ++nt) { xr[nt] = (f32x4){0.f, 0.f, 0.f, 0.f}; xi[nt] = (f32x4){0.f, 0.f, 0.f, 0.f}; }
#pragma unroll 2
    for (int ks = 0; ks < 8; ++ks) {
        const bf16x8 a_re = *(const bf16x8*)(Amat + (size_t)(re_row0 + 16 * w + r16) * 256 + 32 * ks + 8 * g), a_im = *(const bf16x8*)(Amat + (size_t)(im_row0 + 16 * w + r16) * 256 + 32 * ks + 8 * g);
#pragma unroll
        for (int nt = 0; nt < 8; ++nt) { const bf16x8 bfr = tr16x2(YN + (32 * ks + 8 * g + (r16 >> 2)) * 136 + 16 * nt + 4 * (r16 & 3), 4 * 136); xr[nt] = MFMA16(a_re, bfr, xr[nt]); xi[nt] = MFMA16(a_im, bfr, xi[nt]); }
    }
    __syncthreads();
    LAS bf16* XT = YN;
#pragma unroll
    for (int nt = 0; nt < 8; ++nt)
#pragma unroll
        for (int j = 0; j < 4; ++j) { LAS bf16* xp = XT + (16 * w + 4 * g + j) * 264 + (nt >> 2) * 128 + 16 * (nt & 3) + r16; xp[0] = (bf16)f2bf(xr[nt][j]); xp[64] = (bf16)f2bf(xi[nt][j]); }
    __syncthreads();
#pragma unroll 1
    for (int gl = 0; gl < 2; ++gl) {
        const int gg = 2 * hc + gl;
        f32x4 acc[4];
#pragma unroll
        for (int nt = 0; nt < 4; ++nt) acc[nt] = (f32x4){0.f, 0.f, 0.f, 0.f};
#pragma unroll
        for (int ks = 0; ks < 4; ++ks) {
            const bf16x8 af = *(const LAS bf16x8*)(XT + (16 * w + r16) * 264 + gl * 128 + 32 * ks + 8 * g);
#pragma unroll
            for (int nt = 0; nt < 4; ++nt) { const bf16x8 bfr = *(const bf16x8*)(Wfc + ((size_t)gg * 64 + 16 * nt + r16) * 128 + 32 * ks + 8 * g); acc[nt] = MFMA16(af, bfr, acc[nt]); }
        }
#pragma unroll
        for (int j = 0; j < 4; ++j) { const size_t tok = (size_t)tok0 + (size_t)(16 * w + 4 * g + j) * tok_stride;
#pragma unroll
            for (int nt = 0; nt < 4; ++nt) { const int d = 16 * nt + r16; O[tok * 1024 + 512 + gg * 64 + d] = (bf16)f2bf(acc[nt][j] + bfour[gg * 64 + d]); } }
    }
}

#define XB_TMO      128
#define XB_XCNT(j)  (256  + 64 * (j))
#define XB_XSUB(j)  (1280 + 64 * (j))
#define XB_XGEN(j)  (2304 + 64 * (j))
#define XB_TOP      3328
#define XB_TOPGEN   3392
#define XCD_BAR_WORDS 3456
#define XB_SPIN_CAP (1u << 18)

__device__ __forceinline__ unsigned xb_ld(unsigned* p)              { return __hip_atomic_load(p, __ATOMIC_RELAXED, __HIP_MEMORY_SCOPE_AGENT); }
__device__ __forceinline__ unsigned xb_add(unsigned* p, unsigned v) { return __hip_atomic_fetch_add(p, v, __ATOMIC_RELAXED, __HIP_MEMORY_SCOPE_AGENT); }
__device__ __forceinline__ unsigned xb_xcc_id() { return (unsigned)__builtin_amdgcn_s_getreg((3 << 11) | 20) & 0xFu; }
#define XB_SPIN(cond, bar) do { unsigned _sp = 0; while (cond) { __builtin_amdgcn_s_sleep(1); \
    if ((++_sp & 255u) == 0u) { if (xb_ld(&(bar)[XB_TMO])) break; if (_sp > XB_SPIN_CAP) { atomicAdd(&(bar)[XB_TMO], 1u); break; } } } } while (0)

struct XcdBarrier {
    unsigned* bar; unsigned x;
    volatile LAS unsigned* st;
};

__device__ __forceinline__ XcdBarrier xcd_barrier_post(unsigned* bar, volatile LAS unsigned* st) {
    XcdBarrier b; b.bar = bar; b.x = xb_xcc_id(); b.st = st;
    if (threadIdx.x == 0) (void)xb_add(&bar[XB_XCNT(b.x)], 1u);
    return b;
}
__device__ __forceinline__ void xcd_barrier_complete(unsigned* bar, unsigned x, unsigned& nloc, unsigned& nx) {
    const unsigned G = gridDim.x * gridDim.y * gridDim.z;
    unsigned sum, cnt, mine, sp = 0u;
    for (;;) {
        sum = 0u; cnt = 0u; mine = 0u;
#pragma unroll
        for (unsigned j = 0; j < 16; ++j) { const unsigned c = xb_ld(&bar[XB_XCNT(j)]); sum += c; cnt += (c > 0u) ? 1u : 0u; mine = (j == x) ? c : mine; }
        if (sum == G) break;
        __builtin_amdgcn_s_sleep(1);
        if ((++sp & 255u) == 0u) { if (xb_ld(&bar[XB_TMO])) break; if (sp > XB_SPIN_CAP) { atomicAdd(&bar[XB_TMO], 1u); break; } }
    }
    nloc = mine > 0u ? mine : 1u; nx = cnt > 0u ? cnt : 1u;
}

__device__ __forceinline__ void xcd_barrier(const XcdBarrier& b) {
    asm volatile("s_waitcnt vmcnt(0)" ::: "memory");
    __syncthreads();
    if (threadIdx.x == 0) {
        unsigned* bar = b.bar;
        __builtin_amdgcn_s_waitcnt(0);
        unsigned nloc = b.st[0], nx = b.st[1];
        if (nloc == 0u) { xcd_barrier_complete(bar, b.x, nloc, nx); b.st[0] = nloc; b.st[1] = nx; }
        const unsigned old = xb_add(&bar[XB_XSUB(b.x)], 1u);
        const unsigned gen = old / nloc;
        if (old + 1u == (gen + 1u) * nloc) {
            __builtin_amdgcn_fence(__ATOMIC_RELEASE, "agent");
            asm volatile("s_waitcnt vmcnt(0)" ::: "memory");
            const unsigned og = xb_add(&bar[XB_TOP], 1u);
            const unsigned tg = og / nx;
            if (og + 1u == (tg + 1u) * nx) xb_add(&bar[XB_TOPGEN], 1u);
            else XB_SPIN(xb_ld(&bar[XB_TOPGEN]) == tg, bar);
            __builtin_amdgcn_fence(__ATOMIC_ACQUIRE, "agent");
            xb_add(&bar[XB_XGEN(b.x)], 1u);
            asm volatile("s_waitcnt vmcnt(0)" ::: "memory");
        } else {
            XB_SPIN(xb_ld(&bar[XB_XGEN(b.x)]) == gen, bar);
            __builtin_amdgcn_fence(__ATOMIC_ACQUIRE, "agent");
            asm volatile("s_waitcnt vmcnt(0)" ::: "memory");
        }
    }
    __syncthreads();
}

#ifndef REP_PB
#define REP_PB 1
#endif
#ifndef REP_PC
#define REP_PC 1
#endif
#ifndef REP_PD
#define REP_PD 1
#endif
#ifndef REP_PG
#define REP_PG 1
#endif
#define WSP(T, off) ((T*)(ws + (off)))
__global__ void __launch_bounds__(512, 2) fwd_megakernel(Params p_unused) {
    extern __shared__ __attribute__((aligned(16))) unsigned char lds[];
    cg::grid_group grid = cg::this_grid();
    LAS unsigned char* L = (LAS unsigned char*)lds;
    volatile LAS unsigned* xb_st = (volatile LAS unsigned*)(L + LDS_BYTES - 64);
    if (threadIdx.x < 2) xb_st[threadIdx.x] = 0u;
    __syncthreads();
    { XcdBarrier b0 = xcd_barrier_post((unsigned*)(kparams()->ws), xb_st); (void)b0; }
#define GSYNC() do { XcdBarrier b_; b_.bar = (unsigned*)(kparams()->ws); b_.x = xb_xcc_id(); b_.st = xb_st; xcd_barrier(b_); } while (0)

    {
        KP k = kparams();
        const int G = gridDim.x, bid = blockIdx.x;
        for (int it = bid; it < 192; it += G) ada_item(L, k, it);
        __syncthreads();
    }
    {
        KP k = kparams(); unsigned char* ws = k->ws;
        const int tid = threadIdx.x, lane = tid & 63, w = tid >> 6, G = gridDim.x, gw = blockIdx.x * 8 + w, NGW = G * 8;
        LAS float* scr = (LAS float*)(L + w * 16384);
        constexpr int I_IN = 16 * 48, I_OUT = 16 * 32, I_F1 = 16 * 176, I_F2 = 44 * 32, PER_L = I_IN + I_OUT + I_F1 + I_F2;
        for (int it = gw; it < 2 * PER_L; it += NGW) {
            const int l = it / PER_L; int r = it % PER_L;
            if (r < I_IN) { transpose_item(k->in[I_WIN] + (size_t)l * 1024 * 1536, 1024, 1536, WSP(bf16, WS_WIN) + (size_t)l * 1536 * 1024, 0, scr, r, lane); continue; } r -= I_IN;
            if (r < I_OUT) { transpose_item(k->in[I_WOUT] + (size_t)l * 1024 * 1024, 1024, 1024, WSP(bf16, WS_WOUT) + (size_t)l * 1024 * 1024, 0, scr, r, lane); continue; } r -= I_OUT;
            if (r < I_F1) { transpose_item(k->in[I_WF1] + (size_t)l * 1024 * 5632, 1024, 5632, WSP(bf16, WS_WF1) + (size_t)l * 5632 * 1024, 1, scr, r, lane); continue; } r -= I_F1;
            transpose_item(k->in[I_WF2] + (size_t)l * 2816 * 1024, 2816, 1024, WSP(bf16, WS_WF2) + (size_t)l * 1024 * 2816, 0, scr, r, lane);
        }
    }
    tables(kparams(), blockIdx.x * 512 + threadIdx.x, gridDim.x * 512);
    grid.sync();

    {
        KP k = kparams(); unsigned char* ws = k->ws;
        const int tid = threadIdx.x, lane = tid & 63, w = tid >> 6, gw = blockIdx.x * 8 + w, NGW = gridDim.x * 8;
        const float* MOD = WSP(const float, WS_MOD);
        for (int r = gw; r < MROWS; r += NGW) {
            const bool isc = r >= NTOK; const float* md = MOD + (isc ? 6144 : 0);
            const float* src = isc ? k->in[I_CTX] + (size_t)(r - NTOK) * DM : k->in[I_X] + (size_t)r * DM;
            ln_row(src, nullptr, nullptr, nullptr, WSP(bf16, WS_H) + (size_t)r * DM, md, md + 1024, lane);
        }
    }
    GSYNC();

#pragma unroll
    for (int l = 0; l < 2; ++l) {
        const bool first = (l == 0);
        const int Mrows = first ? MROWS : NTOK;
        for (int rep_ = 0; rep_ < REP_PB; ++rep_) { if (rep_) GSYNC();
        {
            KP k = kparams(); unsigned char* ws = k->ws;
            pg8::Gemm g{WSP(bf16, WS_H), WSP(bf16, WS_WIN) + (size_t)l * 1536 * 1024, Mrows, DIN, DM};
            pg8::OrderX S; S.init(Mrows, DIN, gridDim.x, blockIdx.x, first ? 0 : 1, 2);
            pg8::EpiIn E{WSP(bf16, WS_Q), WSP(const float, WS_ROPE)};
            pg8::gemm_phase<pg8::EpiIn, pg8::OrderX, true, true>(L, g, S, E);
        }
        }
        GSYNC();
        for (int rep_ = 0; rep_ < REP_PC; ++rep_) { if (rep_) GSYNC();
        {
            const int n_att = first ? 260 : 256, n_f1 = 256, n_sgu = first ? 130 : 128;
            const int G = gridDim.x;
            for (int u = blockIdx.x; u < n_att + n_f1 + n_sgu; u += G) {
                KP k = kparams(); unsigned char* ws = k->ws;
                if (u < n_att) {
                    const float* sink = k->in[I_SINK] + l * 8;
                    if (u < 256) { const int nb = u >> 1, kvh = u & 1; const int wlo = (nb > 0 ? 2 * (nb - 1) : 0), whi = (2 * (nb + 2) < 256 ? 2 * (nb + 2) : 256);

#ifndef NO_ATT
#ifdef ATT_REF
                        for (int hh = 0; hh < 4; ++hh) attn_unit_ref(WSP(bf16, WS_Q), WSP(bf16, WS_K), WSP(bf16, WS_V), WSP(bf16, WS_O), sink, 128 * nb, 128 * nb, 4 * kvh + hh, wlo, whi);
#else
                        attn_unit(L, WSP(bf16, WS_Q), WSP(bf16, WS_K), WSP(bf16, WS_V), WSP(bf16, WS_O), sink, 128 * nb, 128 * nb, kvh, wlo, whi);
#endif
#endif
 }
                    else { const int cu = u - 256;
#ifndef NO_ATT
 attn_unit(L, WSP(bf16, WS_Q), WSP(bf16, WS_K), WSP(bf16, WS_V), WSP(bf16, WS_O), sink, NTOK + 128 * (cu >> 1), 0, cu & 1, 0, 0);
#endif
 }
                } else if (u < n_att + n_f1) { const int it = u - n_att;
#ifndef NO_F1
 fft1_item(L, WSP(bf16, WS_F), WSP(bf16, WS_Y), WSP(const bf16, WS_W1), WSP(const float, WS_TW), it >> 1, it & 1);
#endif
 }
                else { const int ch = u - n_att - n_f1;

#ifndef NO_SGU
                    sgu_unit(L, WSP(bf16, WS_U), WSP(bf16, WS_G), WSP(bf16, WS_O), WSP(const bf16, WS_WS) + (size_t)l * 4 * 128 * 128, k->in[I_BSP] + l * 512, k->in[I_SLNG] + l * 256, k->in[I_SLNB] + l * 256, 128 * ch);
#endif
 }
            }
        }
        }
        GSYNC();
        for (int rep_ = 0; rep_ < REP_PD; ++rep_) { if (rep_) GSYNC();
        {
            const int n_f2 = first ? 260 : 256;
            const int G = gridDim.x;
            for (int u = blockIdx.x; u < n_f2; u += G) {
                KP k = kparams(); unsigned char* ws = k->ws;
                const bf16* wfc_l = WSP(const bf16, WS_WFC) + (size_t)(l * 2 + 0) * 4 * 64 * 128; const bf16* wfc_c = WSP(const bf16, WS_WFC) + (size_t)(l * 2 + 1) * 4 * 64 * 128;
                const float* bfo = k->in[I_BFOUR] + l * 256;
                if (u < 256) { const int k1 = u >> 1, hc = u & 1;
#ifndef NO_F2
 fft2_item(L, WSP(bf16, WS_Y) + (size_t)k1 * 512, 256, 65536, WSP(const bf16, WS_W2), 0, 128, wfc_l, bfo, WSP(bf16, WS_O), k1, 128, hc);
#endif
 }
                else { const int cu = u - 256, mh = cu >> 1, hc = cu & 1;
#ifndef NO_F2
 fft2_item(L, WSP(bf16, WS_F) + (size_t)NTOK * 256, 32768, 256, WSP(const bf16, WS_WC), 128 * mh, 256 + 128 * mh, wfc_c, bfo, WSP(bf16, WS_O), NTOK + 128 * mh, 1, hc);
#endif
 }
            }
        }
        }
        GSYNC();
        {
            KP k = kparams(); unsigned char* ws = k->ws;
            const float* modl = WSP(const float, WS_MOD) + (size_t)l * 2 * 6144;
            pg8::Gemm g{WSP(bf16, WS_O), WSP(bf16, WS_WOUT) + (size_t)l * 1024 * 1024, Mrows, DM, DM};
            pg8::OrderX S; S.init(Mrows, DM, gridDim.x, blockIdx.x, 0, 0);
            pg8::EpiRes E{first ? k->in[I_X] : (const float*)k->out, k->out, modl + 2048, k->in[I_CTX], WSP(float, WS_XC), modl + 6144 + 2048, ALPHA_DN};
            pg8::gemm_phase<pg8::EpiRes, pg8::OrderX, true, true>(L, g, S, E);
        }
        GSYNC();
        {
            KP k = kparams(); unsigned char* ws = k->ws;
            const int tid = threadIdx.x, lane = tid & 63, w = tid >> 6, gw = blockIdx.x * 8 + w, NGW = gridDim.x * 8;
            const float* modl = WSP(const float, WS_MOD) + (size_t)l * 2 * 6144;
            for (int r = gw; r < Mrows; r += NGW) {
                const bool isc = r >= NTOK; const float* md = modl + (isc ? 6144 : 0);
                float* row = isc ? WSP(float, WS_XC) + (size_t)(r - NTOK) * DM : k->out + (size_t)r * DM;
                ln_row(row, row, k->in[I_LN1G] + l * DM, k->in[I_LN1B] + l * DM, WSP(bf16, WS_H) + (size_t)r * DM, md + 3072, md + 4096, lane);
            }
        }
        GSYNC();
        for (int rep_ = 0; rep_ < REP_PG; ++rep_) { if (rep_) GSYNC();
        {
            KP k = kparams(); unsigned char* ws = k->ws;
            pg8::Gemm g{WSP(bf16, WS_H), WSP(bf16, WS_WF1) + (size_t)l * 5632 * 1024, Mrows, 2 * DFF, DM};
            pg8::OrderX S; S.init(Mrows, 2 * DFF, gridDim.x, blockIdx.x, 0, 0);
            pg8::EpiSwiglu E{WSP(bf16, WS_HMID), DFF};
            pg8::gemm_phase<pg8::EpiSwiglu, pg8::OrderX, true, true>(L, g, S, E);
        }
        }
        GSYNC();
        {
            KP k = kparams(); unsigned char* ws = k->ws;
            const float* modl = WSP(const float, WS_MOD) + (size_t)l * 2 * 6144;
            pg8::Gemm g{WSP(bf16, WS_HMID), WSP(bf16, WS_WF2) + (size_t)l * 1024 * 2816, Mrows, DM, DFF};
            pg8::OrderX S; S.init(Mrows, DM, gridDim.x, blockIdx.x, 0, 0);
            pg8::EpiRes E{k->out, k->out, modl + 5120, WSP(float, WS_XC), WSP(float, WS_XC), modl + 6144 + 5120, ALPHA_DN};
            pg8::gemm_phase<pg8::EpiRes, pg8::OrderX, true, true>(L, g, S, E);
        }
        GSYNC();
        {
            KP k = kparams(); unsigned char* ws = k->ws;
            const int tid = threadIdx.x, lane = tid & 63, w = tid >> 6, gw = blockIdx.x * 8 + w, NGW = gridDim.x * 8;
            for (int r = gw; r < Mrows; r += NGW) {
                const bool isc = r >= NTOK; const float* mdn = WSP(const float, WS_MOD) + (size_t)2 * 6144 + (isc ? 6144 : 0);
                float* row = isc ? WSP(float, WS_XC) + (size_t)(r - NTOK) * DM : k->out + (size_t)r * DM;
                ln_row(row, row, k->in[I_LN2G] + l * DM, k->in[I_LN2B] + l * DM, first ? WSP(bf16, WS_H) + (size_t)r * DM : nullptr, mdn, mdn + 1024, lane);
            }
        }
        if (first) GSYNC();
    }
}

extern "C" void kernel_launch(void* const* d_in, const int* in_sizes, int n_in, void* d_out, int out_size, void* d_ws, size_t ws_size, hipStream_t stream) {
    static int grid_blocks = 0;
    if (!grid_blocks) {
        int dev = 0, cus = 0, per_cu = 0;
        hipGetDevice(&dev);
        hipDeviceGetAttribute(&cus, hipDeviceAttributeMultiprocessorCount, dev);
        hipFuncSetAttribute((const void*)fwd_megakernel, hipFuncAttributeMaxDynamicSharedMemorySize, LDS_BYTES);
        hipOccupancyMaxActiveBlocksPerMultiprocessor(&per_cu, (const void*)fwd_megakernel, 512, LDS_BYTES);
        if (per_cu < 1) per_cu = 1;
        grid_blocks = cus * per_cu;
        if (n_in != 21 || ws_size < WS_END) fprintf(stderr, "kernel_launch: unexpected n_in %d or ws_size %zu\n", n_in, ws_size);
    }
    if (hipMemsetAsync(d_ws, 0, 16384, stream) != hipSuccess) fprintf(stderr, "kernel_launch: memset of barrier words failed\n");
    Params p{};
    for (int i = 0; i < 21; ++i) p.in[i] = (const float*)d_in[i];
    p.out = (float*)d_out; p.ws = (unsigned char*)d_ws;
    void* args[] = {&p};
    hipError_t e = hipLaunchCooperativeKernel((const void*)fwd_megakernel, dim3(grid_blocks), dim3(512), args, LDS_BYTES, stream);
    if (e != hipSuccess) fprintf(stderr, "cooperative launch failed: %s (grid %d)\n", hipGetErrorString(e), grid_blocks);
}
```

```cpp
#include <hip/hip_runtime.h>
#include <hip/hip_cooperative_groups.h>
#include <cstdio>
#include <cstdint>
#define LAS __attribute__((address_space(3)))
namespace pg8 {
#define PG8_LAS __attribute__((address_space(3)))
typedef unsigned short bf16_t;
typedef short bf16x8 __attribute__((ext_vector_type(8)));
typedef float f32x4 __attribute__((ext_vector_type(4)));
typedef unsigned u32x4 __attribute__((ext_vector_type(4)));
constexpr int BM = 256, BK = 64, HALF = 128, HTB = HALF * BK * 2  , STAGE_BYTES = 8 * HTB, NXCD = 8, WGM = 8;

__host__ __device__ __forceinline__ int lds_byte(int r, int c) { const int st = (r >> 4) * 2 + (c >> 5), rr = r & 15, cc = c & 31, ob = rr * 64 + cc * 2; return st * 1024 + (ob ^ (((ob >> 9) & 1) << 5)); }
__host__ __device__ __forceinline__ void stage_rc(int b, int& R, int& C) { const int st = b / 1024, sb = b % 1024, swz = sb ^ (((sb >> 9) & 1) << 5); R = (st >> 1) * 16 + swz / 64; C = (st & 1) * 32 + (swz % 64) / 2; }
__host__ __device__ __forceinline__ int perm32(int rho) { const int n = rho >> 4, i = rho & 15; return 8 * (i >> 2) + 4 * n + (i & 3); }

struct Unit { int pm, pn; };
struct Gemm { const bf16_t* A; const bf16_t* Bt; int M, N, K; };

struct StaticOrder {
    int nM, nN, nwg, G, c;
    __host__ __device__ void init(int M, int N, int G_, int c_) { nM = M / BM; nN = N / BM; nwg = nM * nN; G = G_; c = c_; }
    __host__ __device__ bool next(int i, Unit& u) const {
        const long L = (long)i * G + c; if (L >= nwg) return false;
        int wgid = (int)L; { const int q = nwg / NXCD, r = nwg % NXCD, xcd = wgid % NXCD, off = wgid / NXCD; wgid = (xcd < r ? xcd * (q + 1) : r * (q + 1) + (xcd - r) * q) + off; }
        const int nig = WGM * nN, gid = wgid / nig, fm = gid * WGM, gsz = (nM - fm) < WGM ? (nM - fm) : WGM;
        u.pm = fm + ((wgid % nig) % gsz); u.pn = (wgid % nig) / gsz; return true;
    }
    __device__ __forceinline__ void a_ready(const Unit&) const {}
    __device__ __forceinline__ void done(const Unit&) const {}
};

__device__ __forceinline__ unsigned cvt_pk_bf16(float lo, float hi) { unsigned r; asm volatile("v_cvt_pk_bf16_f32 %0, %1, %2" : "=v"(r) : "v"(lo), "v"(hi)); return r; }
typedef float f32x2 __attribute__((ext_vector_type(2)));
template <class Epi, class Sched, bool ALIGN_EPI = false, bool SP2 = false>
__device__ __forceinline__ void gemm_phase(PG8_LAS unsigned char* lds, const Gemm g, const Sched& S, const Epi& E) {
    int tid_ = threadIdx.x; asm volatile("" : "+v"(tid_));
    const int tid = tid_, wid = __builtin_amdgcn_readfirstlane(tid >> 6), lane = tid & 63, wr = wid >> 2, wc = wid & 3, fr = lane & 15, fq = lane >> 4;
    const int K = g.K, nt = K / BK;
    unsigned voffA[2], voffB[2];
#pragma unroll
    for (int i = 0; i < 2; ++i) { int R, C; stage_rc(tid * 16 + i * 8192, R, C); const int Rb = Epi::PERM ? ((R & ~31) + perm32(R & 31)) : R;
        voffA[i] = (unsigned)(R * K + C) * 2u; voffB[i] = (unsigned)(Rb * K + C) * 2u; }
    const size_t kstep = (size_t)(BK * 2);
    const size_t hstep = (size_t)HALF * K * 2;
    const size_t tstep = 2 * hstep;
    const unsigned ldsw = (unsigned)wid * 1024u;
    const int aoff = lds_byte(wr * 64 + fr, fq * 8), boff = lds_byte(wc * 32 + fr, fq * 8);
#define PG8_SA(b, h) (((b) * 2 + (h)) * HTB)
#define PG8_SB(b, h) ((4 + (b) * 2 + (h)) * HTB)
#define PG8_STAGE(bufoff, gbase, voff) do { _Pragma("unroll") for (int _i = 0; _i < 2; ++_i) \
        __builtin_amdgcn_global_load_lds((const unsigned*)((const char*)(gbase) + (voff)[_i]), (PG8_LAS unsigned*)(lds + (bufoff) + ldsw + _i * 8192), 16, 0, 0); } while (0)
#define PG8_LDA(dst, b, h) do { _Pragma("unroll") for (int m = 0; m < 4; ++m) _Pragma("unroll") for (int k = 0; k < 2; ++k) dst[m][k] = *(const PG8_LAS bf16x8*)(lds + PG8_SA(b, h) + aoff + m * 2048 + k * 1024); } while (0)
#define PG8_LDB(dst, b, h) do { _Pragma("unroll") for (int n = 0; n < 2; ++n) _Pragma("unroll") for (int k = 0; k < 2; ++k) dst[n][k] = *(const PG8_LAS bf16x8*)(lds + PG8_SB(b, h) + boff + n * 2048 + k * 1024); } while (0)
#define PG8_MMA(ai, bj, At, Bt) do { __builtin_amdgcn_s_setprio(1); _Pragma("unroll") for (int m = 0; m < 4; ++m) _Pragma("unroll") for (int n = 0; n < 2; ++n) _Pragma("unroll") for (int k = 0; k < 2; ++k) \
        acc[ai][bj][m][n] = __builtin_amdgcn_mfma_f32_16x16x32_bf16(Bt[n][k], At[m][k], acc[ai][bj][m][n], 0, 0, 0); __builtin_amdgcn_s_setprio(0); } while (0)
#define PG8_WAIT_V(n) asm volatile("s_waitcnt vmcnt(" #n ")" ::: "memory")
#define PG8_WAIT_L(n) asm volatile("s_waitcnt lgkmcnt(" #n ")" ::: "memory")
#define PG8_BAR __builtin_amdgcn_s_barrier()
#define PG8_SCHED __builtin_amdgcn_sched_barrier(0)
    Unit cur, nxt; int ui = 0;
    if (!S.next(0, cur)) return;
    f32x4 acc[2][2][4][2];
#pragma unroll
    for (int a = 0; a < 2; ++a)
#pragma unroll
        for (int b = 0; b < 2; ++b)
#pragma unroll
            for (int m = 0; m < 4; ++m)
#pragma unroll
                for (int n = 0; n < 2; ++n) acc[a][b][m][n] = (f32x4){0.f, 0.f, 0.f, 0.f};
    bf16x8 At[4][2], B0[2][2], B1[2][2];
    const char* cA = (const char*)g.A + (size_t)cur.pm * tstep; const char* cB = (const char*)g.Bt + (size_t)cur.pn * tstep;
    S.a_ready(cur);
    if constexpr (SP2) {
        PG8_STAGE(PG8_SB(0, 0), cB, voffB); PG8_STAGE(PG8_SB(0, 1), cB + hstep, voffB); PG8_STAGE(PG8_SA(0, 0), cA, voffA); PG8_STAGE(PG8_SA(0, 1), cA + hstep, voffA);
        if (wr == 1) PG8_BAR;
        PG8_WAIT_V(2); PG8_BAR;
        PG8_STAGE(PG8_SB(1, 0), cB + kstep, voffB); PG8_STAGE(PG8_SA(1, 0), cA + kstep, voffA); PG8_STAGE(PG8_SB(1, 1), cB + hstep + kstep, voffB);
        PG8_WAIT_V(6); PG8_BAR;
    } else {
        PG8_STAGE(PG8_SB(0, 0), cB, voffB); PG8_STAGE(PG8_SA(0, 0), cA, voffA); PG8_STAGE(PG8_SB(0, 1), cB + hstep, voffB); PG8_STAGE(PG8_SA(0, 1), cA + hstep, voffA);
        if (wr == 1) PG8_BAR;
        PG8_WAIT_V(4); PG8_BAR;
        PG8_STAGE(PG8_SB(1, 0), cB + kstep, voffB); PG8_STAGE(PG8_SA(1, 0), cA + kstep, voffA); PG8_STAGE(PG8_SB(1, 1), cB + hstep + kstep, voffB);
        PG8_WAIT_V(6); PG8_BAR;
    }
    for (;;) {
        const bool has_next = S.next(ui + 1, nxt);
        const char* nA = has_next ? (const char*)g.A + (size_t)nxt.pm * tstep : cA; const char* nB = has_next ? (const char*)g.Bt + (size_t)nxt.pn * tstep : cB;
        for (int t = 0; t < nt; t += 2) {
            const bool last = (t == nt - 2);
            const char* a1 = cA + (size_t)(t + 1) * kstep;
            const char* a2 = last ? nA : cA + (size_t)(t + 2) * kstep; const char* b2 = last ? nB : cB + (size_t)(t + 2) * kstep;
            const char* a3 = a2 + kstep; const char* b3 = b2 + kstep;
            if (last && has_next) S.a_ready(nxt);
            if constexpr (SP2) {
            PG8_LDB(B0, 0, 0); PG8_LDB(B1, 0, 1); PG8_SCHED; PG8_LDA(At, 0, 0); PG8_STAGE(PG8_SA(1, 1), a1 + hstep, voffA);
            PG8_WAIT_V(8); PG8_WAIT_L(0); PG8_BAR; PG8_MMA(0, 0, At, B0); PG8_MMA(0, 1, At, B1); PG8_BAR; PG8_SCHED;
            PG8_LDA(At, 0, 1); PG8_STAGE(PG8_SB(0, 0), b2, voffB); PG8_STAGE(PG8_SB(0, 1), b2 + hstep, voffB); PG8_STAGE(PG8_SA(0, 0), a2, voffA);
            PG8_WAIT_V(8); PG8_WAIT_L(0); PG8_BAR; PG8_MMA(1, 0, At, B0); PG8_MMA(1, 1, At, B1); PG8_BAR; PG8_SCHED;
            PG8_LDB(B0, 1, 0); PG8_LDB(B1, 1, 1); PG8_SCHED; PG8_LDA(At, 1, 0); PG8_STAGE(PG8_SA(0, 1), a2 + hstep, voffA);
            PG8_WAIT_V(8); PG8_WAIT_L(0); PG8_BAR; PG8_MMA(0, 0, At, B0); PG8_MMA(0, 1, At, B1); PG8_BAR; PG8_SCHED;
            PG8_LDA(At, 1, 1); PG8_STAGE(PG8_SB(1, 0), b3, voffB); PG8_STAGE(PG8_SB(1, 1), b3 + hstep, voffB); PG8_STAGE(PG8_SA(1, 0), a3, voffA);
            PG8_WAIT_V(8); PG8_WAIT_L(0); PG8_BAR; PG8_MMA(1, 0, At, B0); PG8_MMA(1, 1, At, B1); PG8_BAR; PG8_SCHED;
            } else {
            PG8_LDB(B0, 0, 0); PG8_SCHED; PG8_LDA(At, 0, 0); PG8_STAGE(PG8_SA(1, 1), a1 + hstep, voffA);
            PG8_WAIT_L(8); PG8_BAR; PG8_WAIT_L(0); PG8_MMA(0, 0, At, B0); PG8_BAR; PG8_SCHED;
            PG8_LDB(B1, 0, 1); PG8_STAGE(PG8_SB(0, 0), b2, voffB);
            PG8_BAR; PG8_WAIT_L(0); PG8_MMA(0, 1, At, B1); PG8_BAR;
            PG8_LDA(At, 0, 1); PG8_STAGE(PG8_SA(0, 0), a2, voffA);
            PG8_BAR; PG8_WAIT_L(0); PG8_MMA(1, 0, At, B0); PG8_BAR; PG8_SCHED;
            PG8_STAGE(PG8_SB(0, 1), b2 + hstep, voffB);
            PG8_WAIT_V(6); PG8_BAR; PG8_MMA(1, 1, At, B1); PG8_BAR;
            PG8_LDB(B0, 1, 0); PG8_SCHED; PG8_LDA(At, 1, 0); PG8_STAGE(PG8_SA(0, 1), a2 + hstep, voffA);
            PG8_WAIT_L(8); PG8_BAR; PG8_WAIT_L(0); PG8_MMA(0, 0, At, B0); PG8_BAR; PG8_SCHED;
            PG8_LDB(B1, 1, 1); PG8_STAGE(PG8_SB(1, 0), b3, voffB);
            PG8_BAR; PG8_WAIT_L(0); PG8_MMA(0, 1, At, B1); PG8_BAR;
            PG8_LDA(At, 1, 1); PG8_STAGE(PG8_SA(1, 0), a3, voffA);
            PG8_BAR; PG8_WAIT_L(0); PG8_MMA(1, 0, At, B0); PG8_BAR; PG8_SCHED;
            PG8_STAGE(PG8_SB(1, 1), b3 + hstep, voffB);
            PG8_WAIT_V(6); PG8_BAR; PG8_MMA(1, 1, At, B1); PG8_BAR;
            }
        }
        if constexpr (ALIGN_EPI) { if (wr == 0) PG8_BAR; }
        if constexpr (!Epi::AFTER_DRAIN) { E(acc, cur, wr, wc, fr, fq); S.done(cur); }
        if (!has_next) break;
#pragma unroll
        for (int a = 0; a < 2; ++a)
#pragma unroll
            for (int b = 0; b < 2; ++b)
#pragma unroll
                for (int m = 0; m < 4; ++m)
#pragma unroll
                    for (int n = 0; n < 2; ++n) acc[a][b][m][n] = (f32x4){0.f, 0.f, 0.f, 0.f};
        cur = nxt; cA = nA; cB = nB; ++ui;
        if constexpr (ALIGN_EPI) { if (wr == 1) PG8_BAR; }
    }
    PG8_WAIT_V(0);
    if constexpr (!ALIGN_EPI) { if (wr == 0) PG8_BAR; }
    PG8_BAR;
    if constexpr (Epi::AFTER_DRAIN) { E.fused(acc, cur, wr, wc, fr, fq, lds, wid, lane); S.done(cur); }
#undef PG8_SA
#undef PG8_SB
#undef PG8_STAGE
#undef PG8_LDA
#undef PG8_LDB
#undef PG8_MMA
#undef PG8_WAIT_V
#undef PG8_WAIT_L
#undef PG8_BAR
#undef PG8_SCHED
}
}

namespace cg = cooperative_groups;
typedef unsigned short bf16;
typedef short bf16x8 __attribute__((ext_vector_type(8)));
typedef short s16x4 __attribute__((ext_vector_type(4)));
typedef float f32x4 __attribute__((ext_vector_type(4)));
typedef unsigned u32x4 __attribute__((ext_vector_type(4)));
typedef unsigned u32x2 __attribute__((ext_vector_type(2)));
#define MFMA16(a, b, c) __builtin_amdgcn_mfma_f32_16x16x32_bf16((a), (b), (c), 0, 0, 0)

constexpr int NTOK = 16384, NCTX = 256, MROWS = NTOK + NCTX, DM = 1024, DFF = 2816, DIN = 1536;
constexpr float ALPHA_DN = 1.41421356237f, LN_EPS = 1e-6f, LOG2E = 1.44269504089f;
constexpr size_t MiB = 1u << 20;
constexpr size_t WS_W1 = 1 * MiB;
constexpr size_t WS_W2 = WS_W1 + 65536;
constexpr size_t WS_WC = WS_W2 + 131072;
constexpr size_t WS_ROPE = WS_WC + 262144;
constexpr size_t WS_TW = WS_ROPE + 32768;
constexpr size_t WS_WS = WS_TW + 131072;
constexpr size_t WS_WFC = WS_WS + 262144;
constexpr size_t WS_MOD = 3 * MiB;
constexpr size_t WS_WIN = 4 * MiB, WS_WOUT = 10 * MiB, WS_WF1 = 14 * MiB, WS_WF2 = 36 * MiB, WS_XC = 47 * MiB, WS_H = 48 * MiB, WS_ACT = 81 * MiB;
constexpr size_t WS_Q = WS_ACT, WS_K = WS_Q + (size_t)MROWS * 512 * 2, WS_V = WS_K + (size_t)MROWS * 128 * 2, WS_F = WS_V + (size_t)MROWS * 128 * 2,
                 WS_U = WS_F + (size_t)MROWS * 256 * 2, WS_G = WS_U + (size_t)MROWS * 256 * 2, WS_O = WS_G + (size_t)MROWS * 256 * 2,
                 WS_Y = WS_O + (size_t)MROWS * 1024 * 2, WS_YEND = WS_Y + (size_t)128 * 128 * 2 * 256 * 2;
constexpr size_t WS_HMID = WS_ACT, WS_END = 200 * MiB;
static_assert(WS_WFC + 262144 <= WS_MOD && WS_YEND <= WS_END && WS_HMID + (size_t)MROWS * DFF * 2 <= WS_END && WS_H + (size_t)MROWS * DM * 2 <= WS_ACT, "ws map");
constexpr int LDS_BYTES = 147456;

__device__ __forceinline__ unsigned f2bf(float f) { unsigned u = __builtin_bit_cast(unsigned, f); return (u + 0x7fffu + ((u >> 16) & 1u)) >> 16; }
__device__ __forceinline__ unsigned pk2(float lo, float hi) { return f2bf(lo) | (f2bf(hi) << 16); }
__device__ __forceinline__ float bf2f(unsigned short b) { return __builtin_bit_cast(float, (unsigned)b << 16); }
__device__ __forceinline__ float wave_sum(float v) {
#pragma unroll
    for (int o = 1; o < 64; o <<= 1) v += __shfl_xor(v, o);
    return v;
}

typedef short v4i16_t __attribute__((ext_vector_type(4)));
__device__ __forceinline__ s16x4 tr16(const LAS bf16* p) { return __builtin_bit_cast(s16x4, __builtin_amdgcn_ds_read_tr16_b64_v4i16((LAS v4i16_t*)p)); }
__device__ __forceinline__ bf16x8 tr16x2(const LAS bf16* p, int hi_off) { const s16x4 lo = tr16(p), hi = tr16(p + hi_off); return __builtin_shufflevector(lo, hi, 0, 1, 2, 3, 4, 5, 6, 7); }
__device__ __forceinline__ int ltid() { int t = threadIdx.x; asm volatile("" : "+v"(t)); return t; }
__device__ __forceinline__ int lbid() { int b = blockIdx.x; asm volatile("" : "+s"(b)); return b; }
__device__ __forceinline__ int lgdim() { int g = gridDim.x; asm volatile("" : "+s"(g)); return g; }
struct Params { const float* in[21]; float* out; unsigned char* ws; };
typedef const __attribute__((address_space(4))) Params* KP;
__device__ __forceinline__ KP kparams() { KP k = (KP)__builtin_amdgcn_kernarg_segment_ptr(); asm volatile("" : "+s"(k)); return k; }
enum { I_X = 0, I_C, I_CTX, I_CCTX, I_WADA, I_BADA, I_WIN, I_WOUT, I_SINK, I_WFOUR, I_BFOUR, I_SLNG, I_SLNB, I_WSP, I_BSP, I_LN1G, I_LN1B, I_WF1, I_WF2, I_LN2G, I_LN2B };

namespace pg8 {
__device__ __forceinline__ float fast_sigmoid(float z) { return __builtin_amdgcn_rcpf(1.0f + __builtin_amdgcn_exp2f(-1.44269504089f * z)); }
__device__ __forceinline__ float gelu_tanh(float x) { const float z = 1.5957691216f * (x + 0.044715f * x * x * x); return x * fast_sigmoid(z); }
__device__ __forceinline__ float silu_f(float x) { return x * fast_sigmoid(x); }
typedef unsigned u32x2 __attribute__((ext_vector_type(2)));

struct EpiIn {
    static constexpr bool PERM = false, AFTER_DRAIN = false;
    int dummy;
    static constexpr size_t OK_ = (size_t)16640 * 512, OV_ = OK_ + (size_t)16640 * 128, OF_ = OV_ + (size_t)16640 * 128, OU_ = OF_ + (size_t)16640 * 256;
    __device__ __forceinline__ void operator()(const f32x4 (&acc)[2][2][4][2], const Unit& u, int wr, int wc, int fr, int fq) const {
        const int pn = u.pn;
        const int rbase = u.pm * BM + wr * 64 + fr;
        unsigned char* ws_ = kparams()->ws; bf16_t* Q = (bf16_t*)(ws_ + WS_Q); const float* rope = (const float*)(ws_ + WS_ROPE);
        if (pn <= 2) {
#pragma unroll
            for (int ai = 0; ai < 2; ++ai)
#pragma unroll
                for (int m = 0; m < 4; ++m) {
                    const int row = rbase + ai * HALF + m * 16;
                    const bool latent = row < 16384;
                    const int pos = latent ? ((wc & 1) ? (row & 63) : (row >> 6)) : 0;
                    const f32x4 cs = *(const f32x4*)(rope + pos * 16 + 4 * fq);
                    const f32x4 sn = *(const f32x4*)(rope + 4096 + pos * 16 + 4 * fq);
#pragma unroll
                    for (int bj = 0; bj < 2; ++bj) {
                        const f32x4 x1 = acc[ai][bj][m][0], x2 = acc[ai][bj][m][1];
                        f32x4 o1 = x1, o2 = x2;
                        const bool isv = (pn == 2 && bj == 1);
                        if (!isv && latent) { o1 = x1 * cs - x2 * sn; o2 = x1 * sn + x2 * cs; }
                        bf16_t* dst;
                        if (pn < 2) { o1 = o1 * 0.18033688011f; o2 = o2 * 0.18033688011f; dst = Q + (size_t)row * 512 + pn * 256 + bj * HALF + wc * 32 + 4 * fq; }
                        else dst = Q + (bj == 0 ? OK_ : OV_) + (size_t)row * 128 + wc * 32 + 4 * fq;
                        u32x2 w0, w1; w0.x = cvt_pk_bf16(o1[0], o1[1]); w0.y = cvt_pk_bf16(o1[2], o1[3]); w1.x = cvt_pk_bf16(o2[0], o2[1]); w1.y = cvt_pk_bf16(o2[2], o2[3]);
                        *(u32x2*)dst = w0; *(u32x2*)(dst + 16) = w1;
                    }
                }
        } else {
            bf16_t* dstb = Q + OF_ + (size_t)(pn - 3) * ((size_t)16640 * 256);
            const bool act = pn >= 4;
#pragma unroll
            for (int ai = 0; ai < 2; ++ai)
#pragma unroll
                for (int m = 0; m < 4; ++m) {
                    const int row = rbase + ai * HALF + m * 16;
#pragma unroll
                    for (int bj = 0; bj < 2; ++bj)
#pragma unroll
                        for (int n = 0; n < 2; ++n) {
                            f32x4 v = acc[ai][bj][m][n];
                            if (act) { v[0] = gelu_tanh(v[0]); v[1] = gelu_tanh(v[1]); v[2] = gelu_tanh(v[2]); v[3] = gelu_tanh(v[3]); }
                            u32x2 w; w.x = cvt_pk_bf16(v[0], v[1]); w.y = cvt_pk_bf16(v[2], v[3]);
                            *(u32x2*)(dstb + (size_t)row * 256 + bj * HALF + wc * 32 + 16 * n + 4 * fq) = w;
                        }
                }
        }
    }
};

struct EpiSwiglu {
    static constexpr bool PERM = true, AFTER_DRAIN = false;
    int dummy;
    __device__ __forceinline__ void operator()(const f32x4 (&acc)[2][2][4][2], const Unit& u, int wr, int wc, int fr, int fq) const {
        const int row0 = u.pm * BM + wr * 64 + fr, col0 = u.pn * HALF + wc * 32 + 8 * fq;
        bf16_t* O = (bf16_t*)(kparams()->ws + WS_HMID); constexpr int ldc = DFF;
#pragma unroll
        for (int ai = 0; ai < 2; ++ai)
#pragma unroll
            for (int m = 0; m < 4; ++m) {
                bf16_t* rowp = O + (size_t)(row0 + ai * HALF + m * 16) * ldc + col0;
                f32x4 h0, h1;
#pragma unroll
                for (int j = 0; j < 4; ++j) { h0[j] = silu_f(acc[ai][0][m][0][j]) * acc[ai][1][m][0][j]; h1[j] = silu_f(acc[ai][0][m][1][j]) * acc[ai][1][m][1][j]; }
                u32x4 w; w.x = cvt_pk_bf16(h0[0], h0[1]); w.y = cvt_pk_bf16(h0[2], h0[3]); w.z = cvt_pk_bf16(h1[0], h1[1]); w.w = cvt_pk_bf16(h1[2], h1[3]);
                *(u32x4*)rowp = w;
            }
    }
};

struct EpiY {
    static constexpr bool PERM = true, AFTER_DRAIN = false;
    int dummy;
    __device__ __forceinline__ void operator()(const f32x4 (&acc)[2][2][4][2], const Unit& u, int wr, int wc, int fr, int fq) const {
        bf16_t* O = (bf16_t*)(kparams()->ws + WS_H);
        const int row0 = u.pm * BM + wr * 64 + fr, col0 = u.pn * BM + wc * 32 + 8 * fq;
#pragma unroll
        for (int ai = 0; ai < 2; ++ai)
#pragma unroll
            for (int m = 0; m < 4; ++m) {
                bf16_t* rowp = O + (size_t)(row0 + ai * HALF + m * 16) * 1024 + col0;
#pragma unroll
                for (int bj = 0; bj < 2; ++bj) { const f32x4 v0 = acc[ai][bj][m][0], v1 = acc[ai][bj][m][1];
                    u32x4 w; w.x = cvt_pk_bf16(v0[0], v0[1]); w.y = cvt_pk_bf16(v0[2], v0[3]); w.z = cvt_pk_bf16(v1[0], v1[1]); w.w = cvt_pk_bf16(v1[2], v1[3]);
                    *(u32x4*)(rowp + bj * HALF) = w; }
            }
    }
};

struct EpiRes {
    static constexpr bool PERM = false, AFTER_DRAIN = false;
    int l, ffn;
    __device__ __forceinline__ void operator()(const f32x4 (&acc)[2][2][4][2], const Unit& u, int wr, int wc, int fr, int fq) const {
        const bool isc = (u.pm == 64);
        KP k = kparams(); unsigned char* ws_ = k->ws; float* xc = (float*)(ws_ + WS_XC); const float alpha = ALPHA_DN;
        const float* gp = (const float*)(ws_ + WS_MOD) + (size_t)(l * 2 + (isc ? 1 : 0)) * 6144 + (ffn ? 5120 : 2048);
        const float* rp = isc ? (ffn ? (const float*)xc : k->in[I_CTX]) : ((ffn || l) ? (const float*)k->out : k->in[I_X]); float* op = isc ? xc : k->out;
        const int row0 = (isc ? 0 : u.pm * BM) + wr * 64 + fr, col0 = u.pn * BM + wc * 32 + 4 * fq;
        f32x4 gv[2][2];
#pragma unroll
        for (int bj = 0; bj < 2; ++bj)
#pragma unroll
            for (int n = 0; n < 2; ++n) gv[bj][n] = *(const f32x4*)(gp + col0 + bj * HALF + n * 16);
#pragma unroll
        for (int ai = 0; ai < 2; ++ai)
#pragma unroll
            for (int m = 0; m < 4; ++m) {
                const size_t off = (size_t)(row0 + ai * HALF + m * 16) * 1024 + col0;
#pragma unroll
                for (int bj = 0; bj < 2; ++bj)
#pragma unroll
                    for (int n = 0; n < 2; ++n) {
                        const f32x4 r = *(const f32x4*)(rp + off + bj * HALF + n * 16);
                        *(f32x4*)(op + off + bj * HALF + n * 16) = r * alpha + gv[bj][n] * acc[ai][bj][m][n];
                    }
            }
    }
};

struct OrderX {
    StaticOrder so; int extra, xpn;
    __device__ void init(int M, int N, int G, int c, int extra_, int xpn_) { so.init(M, N, G, c); extra = extra_; xpn = xpn_; }
    __device__ bool next(int i, Unit& u) const {
        if (so.next(i, u)) return true;
        const long L = (long)i * so.G + so.c;
        if (extra && L == so.nwg) { u.pm = 64; u.pn = xpn; return true; }
        return false;
    }
    __device__ __forceinline__ void a_ready(const Unit&) const {}
    __device__ __forceinline__ void done(const Unit&) const {}
};
struct OrderC {
    int c0, n, c;
    __device__ bool next(int i, Unit& u) const { if (i == 0 && c >= c0 && c - c0 < n) { u.pm = 64; u.pn = c - c0; return true; } return false; }
    __device__ __forceinline__ void a_ready(const Unit&) const {}
    __device__ __forceinline__ void done(const Unit&) const {}
};
struct OrderS {
    StaticOrder so; int active;
    __device__ void init(int M, int N, int Geff, int c) { so.init(M, N, Geff, c); active = c < Geff; }
    __device__ bool next(int i, Unit& u) const { return active && so.next(i, u); }
    __device__ __forceinline__ void a_ready(const Unit&) const {}
    __device__ __forceinline__ void done(const Unit&) const {}
};
}

__device__ __forceinline__ void transpose_item(const float* W, int K, int N, bf16* WT, int mode, LAS float* scr, int item, int lane) {
    const int nblk = N / 32, kb = item / nblk, nb = item % nblk, k0 = 64 * kb, n0 = 32 * nb;
    int r0 = n0;
    if (mode == 1) { r0 = (n0 < DFF) ? (256 * (n0 / 128) + (n0 % 128)) : (256 * ((n0 - DFF) / 128) + 128 + ((n0 - DFF) % 128)); }
#pragma unroll 8
    for (int i = 0; i < 32; ++i) { const int kk = 2 * i + (lane >> 5); scr[kk * 33 + (lane & 31)] = W[(size_t)(k0 + kk) * N + n0 + (lane & 31)]; }
    asm volatile("s_waitcnt lgkmcnt(0)" ::: "memory");
    const int c = lane & 7;
#pragma unroll
    for (int j = 0; j < 4; ++j) { const int n = (lane >> 3) + 8 * j; const LAS float* s = scr + (8 * c) * 33 + n;
        u32x4 o; o.x = pk2(s[0 * 33], s[1 * 33]); o.y = pk2(s[2 * 33], s[3 * 33]); o.z = pk2(s[4 * 33], s[5 * 33]); o.w = pk2(s[6 * 33], s[7 * 33]);
        *(u32x4*)(WT + (size_t)(r0 + n) * K + k0 + 8 * c) = o; }
    asm volatile("s_waitcnt lgkmcnt(0)" ::: "memory");
}

__device__ __forceinline__ void ada_item(LAS unsigned char* lds, KP p, int item) {
    LAS float* sc = (LAS float*)lds;
    LAS float* red = sc + 2048;
    const int tid = threadIdx.x, lane = tid & 63, w = tid >> 6;
    const int l = item / 96, j = item % 96;
    __syncthreads();
    for (int i = tid; i < 2048; i += 512) { const float v = (i < 1024) ? p->in[I_C][i] : p->in[I_CCTX][i - 1024]; sc[i] = v / (1.0f + __expf(-v)); }
    __syncthreads();
    const float* W = p->in[I_WADA] + (size_t)l * 1024 * 6144 + 64 * j + lane;
    float a0 = 0.f, a1 = 0.f;
#pragma unroll 8
    for (int k = 128 * w; k < 128 * w + 128; ++k) { const float wv = W[(size_t)k * 6144]; a0 += sc[k] * wv; a1 += sc[1024 + k] * wv; }
    red[(w * 2 + 0) * 64 + lane] = a0; red[(w * 2 + 1) * 64 + lane] = a1;
    __syncthreads();
    if (tid < 128) {
        const int v = tid >> 6; float s = 0.f;
#pragma unroll
        for (int ww = 0; ww < 8; ++ww) s += red[(ww * 2 + v) * 64 + lane];
        s += p->in[I_BADA][l * 6144 + 64 * j + lane];
        ((float*)(p->ws + WS_MOD))[(l * 2 + v) * 6144 + 64 * j + lane] = s;
    }
}

__device__ __forceinline__ void tables(KP p, int gtid, int gthreads) {
    bf16* W1 = (bf16*)(p->ws + WS_W1); bf16* W2 = (bf16*)(p->ws + WS_W2); bf16* WC = (bf16*)(p->ws + WS_WC);
    float* ROPE = (float*)(p->ws + WS_ROPE); float* TW = (float*)(p->ws + WS_TW); bf16* WSb = (bf16*)(p->ws + WS_WS); bf16* WFC = (bf16*)(p->ws + WS_WFC);
    for (int i = gtid; i < 256 * 128; i += gthreads) { const int row = i >> 7, n1 = i & 127, part = row >> 7, k1 = row & 127; const float s = sinpif((float)((k1 * n1) & 127) * (1.0f / 64.0f)), c = cospif((float)((k1 * n1) & 127) * (1.0f / 64.0f)); W1[i] = (bf16)f2bf(part ? -s : c); }
    for (int i = gtid; i < 256 * 256; i += gthreads) { const int row = i >> 8, kap = i & 255, pp = row >> 7, k2 = row & 127, part = kap >> 7, n2 = kap & 127; const float s = sinpif((float)((k2 * n2) & 127) * (1.0f / 64.0f)), c = cospif((float)((k2 * n2) & 127) * (1.0f / 64.0f));
        const float v = (pp == 0) ? (part == 0 ? c : s) : (part == 0 ? -s : c); W2[i] = (bf16)f2bf(v); }
    for (int i = gtid; i < 512 * 256; i += gthreads) { const int row = i >> 8, n = i & 255, part = row >> 8, k = row & 255; const float s = sinpif((float)((k * n) & 255) * (1.0f / 128.0f)), c = cospif((float)((k * n) & 255) * (1.0f / 128.0f)); WC[i] = (bf16)f2bf(part ? -s : c); }
    for (int i = gtid; i < 256 * 16; i += gthreads) { const int pos = i >> 4, fi = i & 15; const float fr = powf(10000.0f, -(float)(2 * fi) / 32.0f); const float ang = (float)pos * fr; ROPE[i] = cosf(ang); ROPE[4096 + i] = sinf(ang); }
    for (int i = gtid; i < 16384; i += gthreads) { const float s = sinpif((float)i * (1.0f / 8192.0f)), c = cospif((float)i * (1.0f / 8192.0f)); TW[2 * i] = c; TW[2 * i + 1] = s; }
    for (int i = gtid; i < 2 * 4 * 128 * 128; i += gthreads) WSb[i] = (bf16)f2bf(p->in[I_WSP][i]);
    for (int i = gtid; i < 2 * 2 * 4 * 64 * 128; i += gthreads) {
        const int K = i & 127, d = (i >> 7) & 63, g = (i >> 13) & 3, v = (i >> 15) & 1, l = i >> 16, part = K >> 6, cc = K & 63;
        const float* wf = p->in[I_WFOUR] + ((size_t)(l * 4 + g) * 64) * 64 + d; float acc = 0.f;
        for (int m = 0; m < 64; ++m) { const float s = sinpif((float)((m * cc) & 63) * (1.0f / 32.0f)), c = cospif((float)((m * cc) & 63) * (1.0f / 32.0f)); acc += (part ? s : c) * wf[m * 64]; }
        WFC[i] = (bf16)f2bf(acc * (v ? (1.0f / 128.0f) : (1.0f / 1024.0f)));
    }
}

__device__ __forceinline__ void ln_row(const float* in, float* out, const float* ga, const float* be, bf16* hrow, const float* sh, const float* sc, int lane, const bf16* yrow = nullptr, const float* gate = nullptr) {
    f32x4 v[4];
#pragma unroll
    for (int j = 0; j < 4; ++j) v[j] = ((const f32x4*)in)[lane + 64 * j];
    if (yrow) {
#pragma unroll
        for (int j = 0; j < 4; ++j) { const u32x2 yw = ((const u32x2*)yrow)[lane + 64 * j]; const f32x4 g4 = ((const f32x4*)gate)[lane + 64 * j];
            f32x4 y4; y4[0] = bf2f((unsigned short)(yw.x & 0xffffu)); y4[1] = bf2f((unsigned short)(yw.x >> 16)); y4[2] = bf2f((unsigned short)(yw.y & 0xffffu)); y4[3] = bf2f((unsigned short)(yw.y >> 16));
            v[j] = v[j] * ALPHA_DN + g4 * y4; }
    }
    if (ga) {
        float s = 0.f;
#pragma unroll
        for (int j = 0; j < 4; ++j) s += (v[j][0] + v[j][1]) + (v[j][2] + v[j][3]);
        const float mean = wave_sum(s) * (1.0f / DM); float q = 0.f;
#pragma unroll
        for (int j = 0; j < 4; ++j) { v[j] = v[j] - mean; q += (v[j][0] * v[j][0] + v[j][1] * v[j][1]) + (v[j][2] * v[j][2] + v[j][3] * v[j][3]); }
        const float rstd = 1.0f / sqrtf(wave_sum(q) * (1.0f / DM) + LN_EPS);
#pragma unroll
        for (int j = 0; j < 4; ++j) { const f32x4 g4 = ((const f32x4*)ga)[lane + 64 * j], b4 = ((const f32x4*)be)[lane + 64 * j]; v[j] = v[j] * rstd * g4 + b4; ((f32x4*)out)[lane + 64 * j] = v[j]; }
    }
    if (hrow) {
        float s = 0.f;
#pragma unroll
        for (int j = 0; j < 4; ++j) s += (v[j][0] + v[j][1]) + (v[j][2] + v[j][3]);
        const float mean = wave_sum(s) * (1.0f / DM); float q = 0.f;
#pragma unroll
        for (int j = 0; j < 4; ++j) { v[j] = v[j] - mean; q += (v[j][0] * v[j][0] + v[j][1] * v[j][1]) + (v[j][2] * v[j][2] + v[j][3] * v[j][3]); }
        const float rstd = 1.0f / sqrtf(wave_sum(q) * (1.0f / DM) + LN_EPS);
#pragma unroll
        for (int j = 0; j < 4; ++j) { const f32x4 s4 = ((const f32x4*)sh)[lane + 64 * j], c4 = ((const f32x4*)sc)[lane + 64 * j]; const f32x4 h = v[j] * rstd * (c4 + 1.0f) + s4;
            u32x2 w; w.x = pk2(h[0], h[1]); w.y = pk2(h[2], h[3]); ((u32x2*)hrow)[lane + 64 * j] = w; }
    }
}

__device__ __forceinline__ void attn_unit(LAS unsigned char* lds, const bf16* Q, const bf16* K, const bf16* V, bf16* O, const float* sink, int qrow0, int qpos0, int kvh, int wlo, int whi) {
    int tid = threadIdx.x; asm volatile("" : "+v"(tid));
    const int lane = tid & 63, w = tid >> 6, r16 = lane & 15, g = lane >> 4;
    LAS bf16* KS = (LAS bf16*)lds;
    LAS bf16* VS = (LAS bf16*)(lds + 64 * 72 * 2);
    const int hq = 4 * kvh + (w >> 1), qw = 64 * (w & 1);
    LAS bf16* QS = (LAS bf16*)(lds + 18432 + w * 9216);
    __syncthreads();
#pragma unroll 2
    for (int i = 0; i < 8; ++i) { const int idx = lane + 64 * i, qr = idx >> 3, ch = idx & 7;
        *(LAS u32x4*)(QS + qr * 72 + ch * 8) = *(const u32x4*)(Q + (size_t)(qrow0 + qw + qr) * 512 + hq * 64 + ch * 8); }
    f32x4 oacc[4][4];
#pragma unroll
    for (int a = 0; a < 4; ++a)
#pragma unroll
        for (int b = 0; b < 4; ++b) oacc[a][b] = (f32x4){0.f, 0.f, 0.f, 0.f};
    float mrun[4], lrun[4];
    const float sk = sink[hq] * LOG2E;
#pragma unroll
    for (int qt = 0; qt < 4; ++qt) { mrun[qt] = sk; lrun[qt] = (g == 0) ? 1.0f : 0.0f; }
    const int nwin = whi - wlo, ntiles = nwin + 4;
    const int lk = tid >> 3, lc = tid & 7;
    u32x4 kreg, vreg;
    { const int row = (0 < nwin ? wlo * 64 : NTOK) + lk; kreg = *(const u32x4*)(K + (size_t)row * 128 + kvh * 64 + lc * 8); vreg = *(const u32x4*)(V + (size_t)row * 128 + kvh * 64 + lc * 8); }
    for (int t = 0; t < ntiles; ++t) {
        __syncthreads();
        *(LAS u32x4*)(KS + lk * 72 + lc * 8) = kreg;
        *(LAS u32x4*)(VS + lk * 72 + lc * 8) = vreg;
        __syncthreads();
        if (t + 1 < ntiles) { const int tn = t + 1; const int row = (tn < nwin ? (wlo + tn) * 64 : NTOK + (tn - nwin) * 64) + lk;
            kreg = *(const u32x4*)(K + (size_t)row * 128 + kvh * 64 + lc * 8); vreg = *(const u32x4*)(V + (size_t)row * 128 + kvh * 64 + lc * 8); }
        const bool win = t < nwin; const int kpos0 = (wlo + t) * 64;
        const int drel = kpos0 - (qpos0 + qw);
        const bool dead = win && (drel >= 192 || drel <= -192);
        const bool partial = win && (drel == 128 || drel == -128);
        if (!dead) {
#pragma unroll
        for (int qh = 0; qh < 2; ++qh) {
            f32x4 s[4][2];
#pragma unroll
            for (int a = 0; a < 4; ++a)
#pragma unroll
                for (int b = 0; b < 2; ++b) s[a][b] = (f32x4){0.f, 0.f, 0.f, 0.f};
#pragma unroll
            for (int ks = 0; ks < 2; ++ks) {
                bf16x8 kf[4];
#pragma unroll
                for (int kt = 0; kt < 4; ++kt) kf[kt] = *(const LAS bf16x8*)(KS + (16 * kt + r16) * 72 + 32 * ks + 8 * g);
                bf16x8 qfr[2];
#pragma unroll
                for (int q2 = 0; q2 < 2; ++q2) qfr[q2] = *(const LAS bf16x8*)(QS + (16 * (2 * qh + q2) + r16) * 72 + 32 * ks + 8 * g);
#pragma unroll
                for (int kt = 0; kt < 4; ++kt)
#pragma unroll
                    for (int q2 = 0; q2 < 2; ++q2) s[kt][q2] = MFMA16(kf[kt], qfr[q2], s[kt][q2]);
            }
            if (partial) {
#pragma unroll
                for (int kt = 0; kt < 4; ++kt)
#pragma unroll
                    for (int q2 = 0; q2 < 2; ++q2)
#pragma unroll
                        for (int j = 0; j < 4; ++j) { const int d = (kpos0 + 16 * kt + 4 * g + j) - (qpos0 + qw + 16 * (2 * qh + q2) + r16); if (d > 128 || d < -128) s[kt][q2][j] = -INFINITY; }
            }
#pragma unroll
            for (int q2 = 0; q2 < 2; ++q2) {
                const int qt = 2 * qh + q2;
                float mx = -INFINITY;
#pragma unroll
                for (int kt = 0; kt < 4; ++kt)
#pragma unroll
                    for (int j = 0; j < 4; ++j) mx = fmaxf(mx, s[kt][q2][j]);
                mx = fmaxf(mx, __shfl_xor(mx, 16)); mx = fmaxf(mx, __shfl_xor(mx, 32));
                const float mnew = fmaxf(mrun[qt], mx); const float alpha = __builtin_amdgcn_exp2f(mrun[qt] - mnew); mrun[qt] = mnew;
                float ps = 0.f;
#pragma unroll
                for (int kt = 0; kt < 4; ++kt)
#pragma unroll
                    for (int j = 0; j < 4; ++j) { const float pv = __builtin_amdgcn_exp2f(s[kt][q2][j] - mnew); s[kt][q2][j] = pv; ps += pv; }
                lrun[qt] = lrun[qt] * alpha + ps;
#pragma unroll
                for (int dt = 0; dt < 4; ++dt) oacc[dt][qt] = oacc[dt][qt] * alpha;
            }
#pragma unroll
            for (int kp = 0; kp < 2; ++kp) {
                bf16x8 pf[2];
#pragma unroll
                for (int q2 = 0; q2 < 2; ++q2) { u32x4 pw; pw.x = pg8::cvt_pk_bf16(s[2 * kp][q2][0], s[2 * kp][q2][1]); pw.y = pg8::cvt_pk_bf16(s[2 * kp][q2][2], s[2 * kp][q2][3]);
                    pw.z = pg8::cvt_pk_bf16(s[2 * kp + 1][q2][0], s[2 * kp + 1][q2][1]); pw.w = pg8::cvt_pk_bf16(s[2 * kp + 1][q2][2], s[2 * kp + 1][q2][3]); pf[q2] = __builtin_bit_cast(bf16x8, pw); }
#pragma unroll
                for (int dt = 0; dt < 4; ++dt) {
                    const bf16x8 vf = tr16x2(VS + (32 * kp + 4 * g + (r16 >> 2)) * 72 + 16 * dt + 4 * (r16 & 3), 16 * 72);
#pragma unroll
                    for (int q2 = 0; q2 < 2; ++q2) oacc[dt][2 * qh + q2] = MFMA16(vf, pf[q2], oacc[dt][2 * qh + q2]);
                }
            }
            __builtin_amdgcn_sched_barrier(0);
        }
        }
    }
#pragma unroll
    for (int qt = 0; qt < 4; ++qt) {
        float l = lrun[qt]; l += __shfl_xor(l, 16); l += __shfl_xor(l, 32);
        const float inv = 1.0f / l;
        bf16* orow = O + (size_t)(qrow0 + qw + 16 * qt + r16) * 1024 + hq * 64 + 4 * g;
#pragma unroll
        for (int dt = 0; dt < 4; ++dt) { const f32x4 o = oacc[dt][qt] * inv; u32x2 wv; wv.x = pk2(o[0], o[1]); wv.y = pk2(o[2], o[3]); *(u32x2*)(orow + 16 * dt) = wv; }
    }
}

__device__ __forceinline__ void attn_unit_ref(const bf16* Q, const bf16* K, const bf16* V, bf16* O, const float* sink, int qrow0, int qpos0, int hq, int wlo, int whi) {
    int tid = threadIdx.x; asm volatile("" : "+v"(tid));
    const int qi = tid >> 2, part = tid & 3, kvh = hq >> 2;
    float q[16], o[16];
    { const bf16* qp = Q + (size_t)(qrow0 + qi) * 512 + hq * 64 + part * 16;
#pragma unroll
      for (int e = 0; e < 16; ++e) { q[e] = bf2f(qp[e]); o[e] = 0.f; } }
    float m = sink[hq] * LOG2E, l = 1.0f;
    const int nwin = (whi - wlo) * 64, nk = nwin + 256;
#pragma unroll 1
    for (int j = 0; j < nk; ++j) {
        const int row = j < nwin ? wlo * 64 + j : NTOK + (j - nwin);
        const bf16* kp = K + (size_t)row * 128 + kvh * 64 + part * 16; const bf16* vp = V + (size_t)row * 128 + kvh * 64 + part * 16;
        float s = 0.f;
#pragma unroll
        for (int e = 0; e < 16; ++e) s += q[e] * bf2f(kp[e]);
        s += __shfl_xor(s, 1); s += __shfl_xor(s, 2);
        if (j < nwin) { const int d = row - (qpos0 + qi); if (d > 128 || d < -128) s = -INFINITY; }
        const float mn = fmaxf(m, s), a = exp2f(m - mn), pj = exp2f(s - mn); m = mn; l = l * a + pj;
#pragma unroll
        for (int e = 0; e < 16; ++e) o[e] = o[e] * a + pj * bf2f(vp[e]);
    }
    const float inv = 1.0f / l;
    bf16* op = O + (size_t)(qrow0 + qi) * 1024 + hq * 64 + part * 16;
#pragma unroll
    for (int e = 0; e < 16; ++e) op[e] = (bf16)f2bf(o[e] * inv);
}

__device__ __forceinline__ void sgu_unit(LAS unsigned char* lds, const bf16* U, const bf16* G, bf16* O, const bf16* WSb, const float* bs, const float* lng, const float* lnb, int row0, int h0) {
    int tid = threadIdx.x; asm volatile("" : "+v"(tid));
    const int lane = tid & 63, w = tid >> 6, r16 = lane & 15, g = lane >> 4;
    LAS bf16* VN = (LAS bf16*)lds;
    __syncthreads();
    { const int q = tid >> 2, part = tid & 3;
#pragma unroll
      for (int h = h0; h < h0 + 2; ++h) {
        const u32x4 a = *(const u32x4*)(G + (size_t)(row0 + q) * 256 + h * 64 + part * 16), b = *(const u32x4*)(G + (size_t)(row0 + q) * 256 + h * 64 + part * 16 + 8);
        float x[16];
#pragma unroll
        for (int e = 0; e < 4; ++e) { x[2 * e] = bf2f((unsigned short)(a[e] & 0xffffu)); x[2 * e + 1] = bf2f((unsigned short)(a[e] >> 16)); x[8 + 2 * e] = bf2f((unsigned short)(b[e] & 0xffffu)); x[8 + 2 * e + 1] = bf2f((unsigned short)(b[e] >> 16)); }
        float s = 0.f;
#pragma unroll
        for (int e = 0; e < 16; ++e) s += x[e];
        s += __shfl_xor(s, 1); s += __shfl_xor(s, 2);
        const float mean = s * (1.0f / 64.0f); float qq = 0.f;
#pragma unroll
        for (int e = 0; e < 16; ++e) { x[e] -= mean; qq += x[e] * x[e]; }
        qq += __shfl_xor(qq, 1); qq += __shfl_xor(qq, 2);
        const float rstd = 1.0f / sqrtf(qq * (1.0f / 64.0f) + LN_EPS);
#pragma unroll
        for (int e = 0; e < 16; ++e) { const int dd = part * 16 + e; x[e] = x[e] * rstd * lng[h * 64 + dd] + lnb[h * 64 + dd]; }
        { u32x4 w0, w1; w0.x = pk2(x[0], x[1]); w0.y = pk2(x[2], x[3]); w0.z = pk2(x[4], x[5]); w0.w = pk2(x[6], x[7]); w1.x = pk2(x[8], x[9]); w1.y = pk2(x[10], x[11]); w1.z = pk2(x[12], x[13]); w1.w = pk2(x[14], x[15]);
          *(LAS u32x4*)(VN + q * 264 + h * 64 + part * 16) = w0; *(LAS u32x4*)(VN + q * 264 + h * 64 + part * 16 + 8) = w1; }
      } }
    __syncthreads();
#pragma unroll 1
    for (int h = h0; h < h0 + 2; ++h) {
        f32x4 acc[4];
#pragma unroll
        for (int nt = 0; nt < 4; ++nt) acc[nt] = (f32x4){0.f, 0.f, 0.f, 0.f};
#pragma unroll
        for (int ks = 0; ks < 4; ++ks) {
            const bf16x8 af = *(const bf16x8*)(WSb + ((size_t)h * 128 + 16 * w + r16) * 128 + 32 * ks + 8 * g);
#pragma unroll
            for (int nt = 0; nt < 4; ++nt) { const bf16x8 bfr = tr16x2(VN + (32 * ks + 8 * g + (r16 >> 2)) * 264 + h * 64 + 16 * nt + 4 * (r16 & 3), 4 * 264); acc[nt] = MFMA16(af, bfr, acc[nt]); }
        }
#pragma unroll
        for (int j = 0; j < 4; ++j) { const int pp = 16 * w + 4 * g + j; const float bias = bs[h * 128 + pp];
#pragma unroll
            for (int nt = 0; nt < 4; ++nt) { const int col = h * 64 + 16 * nt + r16; const float u = bf2f(U[(size_t)(row0 + pp) * 256 + col]); O[(size_t)(row0 + pp) * 1024 + 768 + col] = (bf16)f2bf(u * (acc[nt][j] + bias)); } }
    }
}

__device__ __forceinline__ void fft1_item(LAS unsigned char* lds, const bf16* F, bf16* Y, const bf16* W1, const float* TW, int n2, int hc) {
    int tid = threadIdx.x; asm volatile("" : "+v"(tid));
    const int lane = tid & 63, w = tid >> 6, r16 = lane & 15, g = lane >> 4;
    LAS bf16* FN = (LAS bf16*)lds;
    __syncthreads();
    { u32x4 sv[4];
#pragma unroll
      for (int i = 0; i < 4; ++i) { const int idx = tid + 512 * i, n1 = idx >> 4, ch = idx & 15; sv[i] = *(const u32x4*)(F + (size_t)(128 * n1 + n2) * 256 + hc * 128 + ch * 8); }
#pragma unroll
      for (int i = 0; i < 4; ++i) { const int idx = tid + 512 * i, n1 = idx >> 4, ch = idx & 15; *(LAS u32x4*)(FN + n1 * 136 + ch * 8) = sv[i]; } }
    __syncthreads();
    f32x4 ar[8], ai[8];
#pragma unroll
    for (int nt = 0; nt < 8; ++nt) { ar[nt] = (f32x4){0.f, 0.f, 0.f, 0.f}; ai[nt] = (f32x4){0.f, 0.f, 0.f, 0.f}; }
#pragma unroll
    for (int ks = 0; ks < 4; ++ks) {
        const bf16x8 a_re = *(const bf16x8*)(W1 + (size_t)(16 * w + r16) * 128 + 32 * ks + 8 * g), a_im = *(const bf16x8*)(W1 + (size_t)(128 + 16 * w + r16) * 128 + 32 * ks + 8 * g);
#pragma unroll
        for (int nt = 0; nt < 8; ++nt) { const bf16x8 bfr = tr16x2(FN + (32 * ks + 8 * g + (r16 >> 2)) * 136 + 16 * nt + 4 * (r16 & 3), 4 * 136); ar[nt] = MFMA16(a_re, bfr, ar[nt]); ai[nt] = MFMA16(a_im, bfr, ai[nt]); }
    }
#pragma unroll
    for (int j = 0; j < 4; ++j) { const int k1 = 16 * w + 4 * g + j; const int m = (n2 * k1) & 16383; const float tc = TW[2 * m], ts = TW[2 * m + 1];
        bf16* yrow = Y + ((size_t)(n2 * 128 + k1) * 2) * 256 + hc * 128 + r16;
#pragma unroll
        for (int nt = 0; nt < 8; ++nt) { const float yr = ar[nt][j] * tc + ai[nt][j] * ts, yi = ai[nt][j] * tc - ar[nt][j] * ts; yrow[16 * nt] = (bf16)f2bf(yr); yrow[256 + 16 * nt] = (bf16)f2bf(yi); } }
}

__device__ __forceinline__ void fft2_item(LAS unsigned char* lds, const bf16* Bsrc, int sA, int sB, const bf16* Amat, int re_row0, int im_row0, const bf16* Wfc, const float* bfour, bf16* O, int tok0, int tok_stride, int hc) {
    int tid = threadIdx.x; asm volatile("" : "+v"(tid));
    const int lane = tid & 63, w = tid >> 6, r16 = lane & 15, g = lane >> 4;
    LAS bf16* YN = (LAS bf16*)lds;
    __syncthreads();
    { u32x4 sv[8];
#pragma unroll
      for (int i = 0; i < 8; ++i) { const int idx = tid + 512 * i, kap = idx >> 4, ch = idx & 15; sv[i] = *(const u32x4*)(Bsrc + (size_t)(kap >> 7) * sA + (size_t)(kap & 127) * sB + hc * 128 + ch * 8); }
#pragma unroll
      for (int i = 0; i < 8; ++i) { const int idx = tid + 512 * i, kap = idx >> 4, ch = idx & 15; *(LAS u32x4*)(YN + kap * 136 + ch * 8) = sv[i]; } }
    __syncthreads();
    f32x4 xr[8], xi[8];
#pragma unroll
    for (int nt = 0; nt < 8; ++nt) { xr[nt] = (f32x4){0.f, 0.f, 0.f, 0.f}; xi[nt] = (f32x4){0.f, 0.f, 0.f, 0.f}; }
#pragma unroll 4
    for (int ks = 0; ks < 8; ++ks) {
        const bf16x8 a_re = *(const bf16x8*)(Amat + (size_t)(re_row0 + 16 * w + r16) * 256 + 32 * ks + 8 * g), a_im = *(const bf16x8*)(Amat + (size_t)(im_row0 + 16 * w + r16) * 256 + 32 * ks + 8 * g);
#pragma unroll
        for (int nt = 0; nt < 8; ++nt) { const bf16x8 bfr = tr16x2(YN + (32 * ks + 8 * g + (r16 >> 2)) * 136 + 16 * nt + 4 * (r16 & 3), 4 * 136); xr[nt] = MFMA16(a_re, bfr, xr[nt]); xi[nt] = MFMA16(a_im, bfr, xi[nt]); }
    }
    __syncthreads();
    LAS bf16* XT = YN;
#pragma unroll
    for (int nt = 0; nt < 8; ++nt)
#pragma unroll
        for (int j = 0; j < 4; ++j) { LAS bf16* xp = XT + (16 * w + 4 * g + j) * 264 + (nt >> 2) * 128 + 16 * (nt & 3) + r16; xp[0] = (bf16)f2bf(xr[nt][j]); xp[64] = (bf16)f2bf(xi[nt][j]); }
    __syncthreads();
#pragma unroll 1
    for (int gl = 0; gl < 2; ++gl) {
        const int gg = 2 * hc + gl;
        f32x4 acc[4];
#pragma unroll
        for (int nt = 0; nt < 4; ++nt) acc[nt] = (f32x4){0.f, 0.f, 0.f, 0.f};
#pragma unroll
        for (int ks = 0; ks < 4; ++ks) {
            const bf16x8 af = *(const LAS bf16x8*)(XT + (16 * w + r16) * 264 + gl * 128 + 32 * ks + 8 * g);
#pragma unroll
            for (int nt = 0; nt < 4; ++nt) { const bf16x8 bfr = *(const bf16x8*)(Wfc + ((size_t)gg * 64 + 16 * nt + r16) * 128 + 32 * ks + 8 * g); acc[nt] = MFMA16(af, bfr, acc[nt]); }
        }
#pragma unroll
        for (int j = 0; j < 4; ++j) { const size_t tok = (size_t)tok0 + (size_t)(16 * w + 4 * g + j) * tok_stride;
#pragma unroll
            for (int nt = 0; nt < 4; ++nt) { const int d = 16 * nt + r16; O[tok * 1024 + 512 + gg * 64 + d] = (bf16)f2bf(acc[nt][j] + bfour[gg * 64 + d]); } }
    }
}

#define XB_TMO      128
#define XB_XCNT(j)  (256  + 64 * (j))
#define XB_XSUB(j)  (1280 + 64 * (j))
#define XB_XGEN(j)  (2304 + 64 * (j))
#define XB_TOP      3328
#define XB_TOPGEN   3392
#define XCD_BAR_WORDS 3456
#define XB_SPIN_CAP (1u << 18)

__device__ __forceinline__ unsigned xb_ld(unsigned* p)              { return __hip_atomic_load(p, __ATOMIC_RELAXED, __HIP_MEMORY_SCOPE_AGENT); }
__device__ __forceinline__ unsigned xb_add(unsigned* p, unsigned v) { return __hip_atomic_fetch_add(p, v, __ATOMIC_RELAXED, __HIP_MEMORY_SCOPE_AGENT); }
__device__ __forceinline__ unsigned xb_xcc_id() { return (unsigned)__builtin_amdgcn_s_getreg((3 << 11) | 20) & 0xFu; }
#define XB_SPIN(cond, bar) do { unsigned _sp = 0; while (cond) { __builtin_amdgcn_s_sleep(1); \
    if ((++_sp & 255u) == 0u) { if (xb_ld(&(bar)[XB_TMO])) break; if (_sp > XB_SPIN_CAP) { atomicAdd(&(bar)[XB_TMO], 1u); break; } } } } while (0)

struct XcdBarrier {
    unsigned* bar; unsigned x;
    volatile LAS unsigned* st;
};

__device__ __forceinline__ XcdBarrier xcd_barrier_post(unsigned* bar, volatile LAS unsigned* st) {
    XcdBarrier b; b.bar = bar; b.x = xb_xcc_id(); b.st = st;
    if (threadIdx.x == 0) (void)xb_add(&bar[XB_XCNT(b.x)], 1u);
    return b;
}
__device__ __forceinline__ void xcd_barrier_complete(unsigned* bar, unsigned x, unsigned& nloc, unsigned& nx) {
    const unsigned G = gridDim.x * gridDim.y * gridDim.z;
    unsigned sum, cnt, mine, sp = 0u;
    for (;;) {
        sum = 0u; cnt = 0u; mine = 0u;
#pragma unroll
        for (unsigned j = 0; j < 16; ++j) { const unsigned c = xb_ld(&bar[XB_XCNT(j)]); sum += c; cnt += (c > 0u) ? 1u : 0u; mine = (j == x) ? c : mine; }
        if (sum == G) break;
        __builtin_amdgcn_s_sleep(1);
        if ((++sp & 255u) == 0u) { if (xb_ld(&bar[XB_TMO])) break; if (sp > XB_SPIN_CAP) { atomicAdd(&bar[XB_TMO], 1u); break; } }
    }
    nloc = mine > 0u ? mine : 1u; nx = cnt > 0u ? cnt : 1u;
}

__device__ __forceinline__ void xcd_barrier(const XcdBarrier& b) {
    asm volatile("s_waitcnt vmcnt(0)" ::: "memory");
    __syncthreads();
    if (threadIdx.x == 0) {
        unsigned* bar = b.bar;
        __builtin_amdgcn_s_waitcnt(0);
        unsigned nloc = b.st[0], nx = b.st[1];
        if (nloc == 0u) { xcd_barrier_complete(bar, b.x, nloc, nx); b.st[0] = nloc; b.st[1] = nx; }
        const unsigned old = xb_add(&bar[XB_XSUB(b.x)], 1u);
        const unsigned gen = old / nloc;
        if (old + 1u == (gen + 1u) * nloc) {
            __builtin_amdgcn_fence(__ATOMIC_RELEASE, "agent");
            asm volatile("s_waitcnt vmcnt(0)" ::: "memory");
            const unsigned og = xb_add(&bar[XB_TOP], 1u);
            const unsigned tg = og / nx;
            if (og + 1u == (tg + 1u) * nx) xb_add(&bar[XB_TOPGEN], 1u);
            else XB_SPIN(xb_ld(&bar[XB_TOPGEN]) == tg, bar);
            __builtin_amdgcn_fence(__ATOMIC_ACQUIRE, "agent");
            xb_add(&bar[XB_XGEN(b.x)], 1u);
            asm volatile("s_waitcnt vmcnt(0)" ::: "memory");
        } else {
            XB_SPIN(xb_ld(&bar[XB_XGEN(b.x)]) == gen, bar);
            __builtin_amdgcn_fence(__ATOMIC_ACQUIRE, "agent");
            asm volatile("s_waitcnt vmcnt(0)" ::: "memory");
        }
    }
    __syncthreads();
}

#ifndef REP_PB
#define REP_PB 1
#endif
#ifndef REP_PC
#define REP_PC 1
#endif
#ifndef REP_PD
#define REP_PD 1
#endif
#ifndef REP_PG
#define REP_PG 1
#endif
#define WSP(T, off) ((T*)(ws + (off)))
__global__ void __launch_bounds__(512, 2) fwd_megakernel(Params p_unused) {
    extern __shared__ __attribute__((aligned(16))) unsigned char lds[];
    cg::grid_group grid = cg::this_grid();
    LAS unsigned char* L = (LAS unsigned char*)lds;
    volatile LAS unsigned* xb_st = (volatile LAS unsigned*)(L + LDS_BYTES - 64);
    if (threadIdx.x < 2) xb_st[threadIdx.x] = 0u;
    __syncthreads();
    { XcdBarrier b0 = xcd_barrier_post((unsigned*)(kparams()->ws), xb_st); (void)b0; }
#define GSYNC() do { XcdBarrier b_; b_.bar = (unsigned*)(kparams()->ws); b_.x = xb_xcc_id(); b_.st = xb_st; xcd_barrier(b_); } while (0)

    {
        KP k = kparams();
        const int G = lgdim(), bid = lbid();
        for (int it = bid; it < 192; it += G) ada_item(L, k, it);
        __syncthreads();
    }
    {
        KP k = kparams(); unsigned char* ws = k->ws;
        const int tid = ltid(), lane = tid & 63, w = tid >> 6, G = lgdim(), gw = lbid() * 8 + w, NGW = G * 8;
        LAS float* scr = (LAS float*)(L + w * 16384);
        constexpr int I_IN = 16 * 48, I_OUT = 16 * 32, I_F1 = 16 * 176, I_F2 = 44 * 32, PER_L = I_IN + I_OUT + I_F1 + I_F2;
        for (int it = gw; it < 2 * PER_L; it += NGW) {
            const int l = it / PER_L; int r = it % PER_L;
            if (r < I_IN) { transpose_item(k->in[I_WIN] + (size_t)l * 1024 * 1536, 1024, 1536, WSP(bf16, WS_WIN) + (size_t)l * 1536 * 1024, 0, scr, r, lane); continue; } r -= I_IN;
            if (r < I_OUT) { transpose_item(k->in[I_WOUT] + (size_t)l * 1024 * 1024, 1024, 1024, WSP(bf16, WS_WOUT) + (size_t)l * 1024 * 1024, 0, scr, r, lane); continue; } r -= I_OUT;
            if (r < I_F1) { transpose_item(k->in[I_WF1] + (size_t)l * 1024 * 5632, 1024, 5632, WSP(bf16, WS_WF1) + (size_t)l * 5632 * 1024, 1, scr, r, lane); continue; } r -= I_F1;
            transpose_item(k->in[I_WF2] + (size_t)l * 2816 * 1024, 2816, 1024, WSP(bf16, WS_WF2) + (size_t)l * 1024 * 2816, 0, scr, r, lane);
        }
    }
    tables(kparams(), lbid() * 512 + ltid(), lgdim() * 512);
    grid.sync();

    {
        KP k = kparams(); unsigned char* ws = k->ws;
        const int tid = ltid(), lane = tid & 63, w = tid >> 6, gw = lbid() * 8 + w, NGW = lgdim() * 8;
        const float* MOD = WSP(const float, WS_MOD);
        for (int r = gw; r < MROWS; r += NGW) {
            const bool isc = r >= NTOK; const float* md = MOD + (isc ? 6144 : 0);
            const float* src = isc ? k->in[I_CTX] + (size_t)(r - NTOK) * DM : k->in[I_X] + (size_t)r * DM;
            ln_row(src, nullptr, nullptr, nullptr, WSP(bf16, WS_H) + (size_t)r * DM, md, md + 1024, lane);
        }
    }
    GSYNC();

#pragma unroll 1
    for (int l = 0; l < 2; ++l) {
        const bool first = (l == 0);
        {
            KP k = kparams(); unsigned char* ws = k->ws;
            const int Mrows = first ? MROWS : NTOK;
            pg8::Gemm g{WSP(bf16, WS_H), WSP(bf16, WS_WIN) + (size_t)l * 1536 * 1024, Mrows, DIN, DM};
            pg8::OrderX S; S.init(Mrows, DIN, lgdim(), lbid(), first ? 0 : 1, 2);
            pg8::EpiIn E{0};
            pg8::gemm_phase<pg8::EpiIn, pg8::OrderX, true, true>(L, g, S, E);
        }
        GSYNC();
        {
            const int n_att = first ? 260 : 256, n_f1 = 256, n_sgu = first ? 260 : 256, n_cf = first ? 4 : 0;
            const int G = lgdim();
            for (int u = lbid(); u < n_att + n_f1 + n_sgu + n_cf; u += G) {
                KP k = kparams(); unsigned char* ws = k->ws;
                if (u < n_att) {
                    const float* sink = k->in[I_SINK] + l * 8;
                    if (u < 256) { const int nb = u >> 1, kvh = u & 1; const int wlo = (nb > 0 ? 2 * (nb - 1) : 0), whi = (2 * (nb + 2) < 256 ? 2 * (nb + 2) : 256);
                        attn_unit(L, WSP(bf16, WS_Q), WSP(bf16, WS_K), WSP(bf16, WS_V), WSP(bf16, WS_O), sink, 128 * nb, 128 * nb, kvh, wlo, whi); }
                    else { const int cu = u - 256; attn_unit(L, WSP(bf16, WS_Q), WSP(bf16, WS_K), WSP(bf16, WS_V), WSP(bf16, WS_O), sink, NTOK + 128 * (cu >> 1), 0, cu & 1, 0, 0); }
                } else if (u < n_att + n_f1) { const int it = u - n_att; fft1_item(L, WSP(bf16, WS_F), WSP(bf16, WS_Y), WSP(const bf16, WS_W1), WSP(const float, WS_TW), it >> 1, it & 1); }
                else if (u < n_att + n_f1 + n_sgu) { const int su = u - n_att - n_f1, ch = su >> 1;
                    sgu_unit(L, WSP(bf16, WS_U), WSP(bf16, WS_G), WSP(bf16, WS_O), WSP(const bf16, WS_WS) + (size_t)l * 4 * 128 * 128, k->in[I_BSP] + l * 512, k->in[I_SLNG] + l * 256, k->in[I_SLNB] + l * 256, 128 * ch, 2 * (su & 1)); }
                else { const int cu = u - n_att - n_f1 - n_sgu, mh = cu >> 1, hc = cu & 1;
                    fft2_item(L, WSP(bf16, WS_F) + (size_t)NTOK * 256, 32768, 256, WSP(const bf16, WS_WC), 128 * mh, 256 + 128 * mh, WSP(const bf16, WS_WFC) + (size_t)(l * 2 + 1) * 4 * 64 * 128, k->in[I_BFOUR] + l * 256, WSP(bf16, WS_O), NTOK + 128 * mh, 1, hc); }
            }
        }
        GSYNC();
        {
            const int G = lgdim();
            for (int u = lbid(); u < 256; u += G) {
                KP k = kparams(); unsigned char* ws = k->ws;
                const int k1 = u >> 1, hc = u & 1;
                fft2_item(L, WSP(bf16, WS_Y) + (size_t)k1 * 512, 256, 65536, WSP(const bf16, WS_W2), 0, 128, WSP(const bf16, WS_WFC) + (size_t)(l * 2 + 0) * 4 * 64 * 128, k->in[I_BFOUR] + l * 256, WSP(bf16, WS_O), k1, 128, hc);
            }
            if (first) {
                __syncthreads();
                KP k = kparams(); unsigned char* ws = k->ws;
                const float* modl = WSP(const float, WS_MOD) + (size_t)l * 2 * 6144;
                pg8::Gemm g{WSP(bf16, WS_O), WSP(bf16, WS_WOUT) + (size_t)l * 1024 * 1024, MROWS, DM, DM};
                pg8::OrderC S{lgdim() - 4, 4, lbid()};
                pg8::EpiY E{0};
                pg8::gemm_phase<pg8::EpiY, pg8::OrderC, true, true>(L, g, S, E);
            }
        }
        GSYNC();
        {
            KP k = kparams(); unsigned char* ws = k->ws;
            const float* modl = WSP(const float, WS_MOD) + (size_t)l * 2 * 6144;
            if (first) {
                const int tid = ltid(), lane = tid & 63, w = tid >> 6, gw = lbid() * 8 + w, NGW = lgdim() * 8;
                for (int r = gw; r < NCTX; r += NGW) { float* row = WSP(float, WS_XC) + (size_t)r * DM; bf16* hr = WSP(bf16, WS_H) + (size_t)(NTOK + r) * DM;
                    ln_row(k->in[I_CTX] + (size_t)r * DM, row, k->in[I_LN1G] + l * DM, k->in[I_LN1B] + l * DM, hr, modl + 6144 + 3072, modl + 6144 + 4096, lane, hr, modl + 6144 + 2048); }
            }
            pg8::Gemm g{WSP(bf16, WS_O), WSP(bf16, WS_WOUT) + (size_t)l * 1024 * 1024, NTOK, DM, DM};
            pg8::OrderX S; S.init(NTOK, DM, lgdim(), lbid(), 0, 0);
            pg8::EpiY E{0};
            pg8::gemm_phase<pg8::EpiY, pg8::OrderX, true, true>(L, g, S, E);
        }
        GSYNC();
        {
            if (first) {
                KP k = kparams(); unsigned char* ws = k->ws;
                pg8::Gemm g{WSP(bf16, WS_H), WSP(bf16, WS_WF1) + (size_t)l * 5632 * 1024, MROWS, 2 * DFF, DM};
                pg8::OrderC S{0, 22, lbid()};
                pg8::EpiSwiglu E{0};
                pg8::gemm_phase<pg8::EpiSwiglu, pg8::OrderC, true, true>(L, g, S, E);
            }
            KP k = kparams(); unsigned char* ws = k->ws;
            const int tid = ltid(), lane = tid & 63, w = tid >> 6, gw = lbid() * 8 + w, NGW = lgdim() * 8;
            const float* modl = WSP(const float, WS_MOD) + (size_t)l * 2 * 6144;
            for (int r = gw; r < NTOK; r += NGW) {
                float* row = k->out + (size_t)r * DM; bf16* hr = WSP(bf16, WS_H) + (size_t)r * DM;
                ln_row(first ? k->in[I_X] + (size_t)r * DM : (const float*)row, row, k->in[I_LN1G] + l * DM, k->in[I_LN1B] + l * DM, hr, modl + 3072, modl + 4096, lane, hr, modl + 2048);
            }
        }
        GSYNC();
        {
            KP k = kparams(); unsigned char* ws = k->ws;
            pg8::Gemm g{WSP(bf16, WS_H), WSP(bf16, WS_WF1) + (size_t)l * 5632 * 1024, NTOK, 2 * DFF, DM};
            pg8::OrderS S; S.init(NTOK, 2 * DFF, first ? lgdim() - 4 : lgdim(), lbid());
            pg8::EpiSwiglu E{0};
            pg8::gemm_phase<pg8::EpiSwiglu, pg8::OrderS, true, true>(L, g, S, E);
            if (first) {
                __syncthreads();
                const float* modl = WSP(const float, WS_MOD) + (size_t)l * 2 * 6144;
                pg8::Gemm g2{WSP(bf16, WS_HMID), WSP(bf16, WS_WF2) + (size_t)l * 1024 * 2816, MROWS, DM, DFF};
                pg8::OrderC S2{lgdim() - 4, 4, lbid()};
                pg8::EpiY E2{0};
                pg8::gemm_phase<pg8::EpiY, pg8::OrderC, true, true>(L, g2, S2, E2);
            }
        }
        GSYNC();
        {
            KP k = kparams(); unsigned char* ws = k->ws;
            const float* modl = WSP(const float, WS_MOD) + (size_t)l * 2 * 6144;
            if (first) {
                const int tid = ltid(), lane = tid & 63, w = tid >> 6, gw = lbid() * 8 + w, NGW = lgdim() * 8;
                const float* mdn = WSP(const float, WS_MOD) + (size_t)3 * 6144;
                for (int r = gw; r < NCTX; r += NGW) { float* row = WSP(float, WS_XC) + (size_t)r * DM; bf16* hr = WSP(bf16, WS_H) + (size_t)(NTOK + r) * DM;
                    ln_row(row, row, k->in[I_LN2G] + l * DM, k->in[I_LN2B] + l * DM, hr, mdn, mdn + 1024, lane, hr, modl + 6144 + 5120); }
            }
            pg8::Gemm g{WSP(bf16, WS_HMID), WSP(bf16, WS_WF2) + (size_t)l * 1024 * 2816, NTOK, DM, DFF};
            pg8::OrderX S; S.init(NTOK, DM, lgdim(), lbid(), 0, 0);
            pg8::EpiY E{0};
            pg8::gemm_phase<pg8::EpiY, pg8::OrderX, true, true>(L, g, S, E);
        }
        GSYNC();
        {
            KP k = kparams(); unsigned char* ws = k->ws;
            const int tid = ltid(), lane = tid & 63, w = tid >> 6, gw = lbid() * 8 + w, NGW = lgdim() * 8;
            const float* mdn = WSP(const float, WS_MOD) + (size_t)2 * 6144;
            for (int r = gw; r < NTOK; r += NGW) {
                float* row = k->out + (size_t)r * DM; bf16* hr = WSP(bf16, WS_H) + (size_t)r * DM;
                ln_row(row, row, k->in[I_LN2G] + l * DM, k->in[I_LN2B] + l * DM, first ? hr : nullptr, mdn, mdn + 1024, lane, hr, WSP(const float, WS_MOD) + (size_t)l * 2 * 6144 + 5120);
            }
        }
        if (first) GSYNC();
    }
}

extern "C" void kernel_launch(void* const* d_in, const int* in_sizes, int n_in, void* d_out, int out_size, void* d_ws, size_t ws_size, hipStream_t stream) {
    static int grid_blocks = 0;
    if (!grid_blocks) {
        int dev = 0, cus = 0, per_cu = 0;
        hipGetDevice(&dev);
        hipDeviceGetAttribute(&cus, hipDeviceAttributeMultiprocessorCount, dev);
        hipFuncSetAttribute((const void*)fwd_megakernel, hipFuncAttributeMaxDynamicSharedMemorySize, LDS_BYTES);
        hipOccupancyMaxActiveBlocksPerMultiprocessor(&per_cu, (const void*)fwd_megakernel, 512, LDS_BYTES);
        if (per_cu < 1) per_cu = 1;
        grid_blocks = cus * per_cu;
        if (n_in != 21 || ws_size < WS_END) fprintf(stderr, "kernel_launch: unexpected n_in %d or ws_size %zu\n", n_in, ws_size);
    }
    if (hipMemsetAsync(d_ws, 0, 16384, stream) != hipSuccess) fprintf(stderr, "kernel_launch: memset of barrier words failed\n");
    Params p{};
    for (int i = 0; i < 21; ++i) p.in[i] = (const float*)d_in[i];
    p.out = (float*)d_out; p.ws = (unsigned char*)d_ws;
    void* args[] = {&p};
    hipError_t e = hipLaunchCooperativeKernel((const void*)fwd_megakernel, dim3(grid_blocks), dim3(512), args, LDS_BYTES, stream);
    if (e != hipSuccess) fprintf(stderr, "cooperative launch failed: %s (grid %d)\n", hipGetErrorString(e), grid_blocks);
}
```
